# Optimizing an MI355X kernel written in HIP

```python
import math
import jax, jax.numpy as jnp
from jax import lax
import numpy as np

D_MODEL = 4096
BATCH = 2
SEQ = 8192
DEPTH = 1

HEAD_DIM = 128
ATTN_HEADS = D_MODEL // (2 * HEAD_DIM)
DN_HEADS = D_MODEL // (2 * HEAD_DIM)
ATTN_WIDTH = ATTN_HEADS * HEAD_DIM
DN_WIDTH = DN_HEADS * HEAD_DIM
MIX_WIDTH = ATTN_WIDTH + DN_WIDTH
DILATED_PATTERNS = ((128, 1), (512, 4), (2048, 16))
ATTN_BLOCK = 128
CONV_WIDTH = 4
DN_CHUNK = 64
NORM_EPS = 1e-6
L2_EPS = 1e-6
IN_SPLITS = tuple(int(c) for c in np.cumsum([ATTN_WIDTH] * 4 + [DN_WIDTH] * 4 + [DN_HEADS]))
IN_WIDTH = 4 * ATTN_WIDTH + 4 * DN_WIDTH + 2 * DN_HEADS

kernel_name = "hybrid_dilated_attn_gated_deltanet_layer"


def rms_norm(x, g):
    xf = x.astype(jnp.float32)
    y = xf * lax.rsqrt(jnp.mean(xf * xf, axis=-1, keepdims=True) + NORM_EPS)
    return (y * g.astype(jnp.float32)).astype(x.dtype)


def alibi_slopes(n_heads):
    start = 2.0 ** (-8.0 / n_heads)
    return jnp.asarray(np.array([start ** (i + 1) for i in range(n_heads)], dtype=np.float32))


def dilated_window_attention(q, k, v, slopes, window, dilation):
    B, S, H, Dh = q.shape
    L = ATTN_BLOCK
    reach = window // dilation
    M = S // dilation
    nb = -(-M // L)
    Mp = nb * L

    def to_blocks(t):
        t = t.reshape(B, M, dilation, H, Dh)
        t = jnp.pad(t, ((0, 0), (0, Mp - M), (0, 0), (0, 0), (0, 0)))
        return t.reshape(B, nb, L, dilation, H, Dh)

    def with_prev(t):
        prev = jnp.pad(t, ((0, 0), (1, 0), (0, 0), (0, 0), (0, 0), (0, 0)))[:, :-1]
        return jnp.concatenate([prev, t], axis=2)

    qb = to_blocks(q)
    kk = with_prev(to_blocks(k))
    vv = with_prev(to_blocks(v))
    scores = jnp.einsum('bnqrhd,bnkrhd->bnrhqk', qb, kk,
                        preferred_element_type=jnp.float32) * (Dh ** -0.5)
    qi = jnp.arange(L)[:, None]
    kj = jnp.arange(2 * L)[None, :]
    dist = qi + L - kj
    key_pos = (jnp.arange(nb)[:, None, None] - 1) * L + kj[None]
    valid = (dist >= 0)[None] & (dist <= reach)[None] & (key_pos >= 0)
    bias = -slopes[:, None, None] * (dist * dilation).astype(jnp.float32)[None]
    scores = jnp.where(valid[None, :, None, None], scores + bias, -jnp.inf)
    lse = jax.nn.logsumexp(scores, axis=-1)
    p = jnp.exp(scores - lse[..., None])
    out = jnp.einsum('bnrhqk,bnkrhd->bnqrhd', p.astype(v.dtype), vv)
    out = out.reshape(B, Mp, dilation, H, Dh)[:, :M].reshape(B, S, H, Dh)
    lse = jnp.transpose(lse, (0, 1, 4, 2, 3)).reshape(B, Mp, dilation, H)[:, :M].reshape(B, S, H)
    return out, lse


def causal_short_conv(x, w):
    K = w.shape[0]
    S = x.shape[1]
    xp = jnp.pad(x, ((0, 0), (K - 1, 0), (0, 0)))
    return sum(xp[:, j:j + S] * w[j] for j in range(K))


def l2_normalize(x):
    return x * lax.rsqrt(jnp.sum(x * x, axis=-1, keepdims=True) + L2_EPS)


def gated_delta_rule(q, k, v, beta, g):
    B, S, H, Dk = q.shape
    Dv = v.shape[-1]
    C = DN_CHUNK
    N = S // C
    q = q * (Dk ** -0.5)

    def chunks(t):
        t = jnp.moveaxis(t, 2, 1)
        return t.reshape((B, H, N, C) + t.shape[3:])

    q, k, v, beta, g = chunks(q), chunks(k), chunks(v), chunks(beta), chunks(g)
    gc = jnp.cumsum(g, axis=-1)
    incl = jnp.tril(jnp.ones((C, C), dtype=bool))
    strict = jnp.tril(jnp.ones((C, C), dtype=bool), k=-1)
    decay = jnp.exp(jnp.where(incl, gc[..., :, None] - gc[..., None, :], -jnp.inf))
    kb = k * beta[..., None]
    a_strict = jnp.where(strict, jnp.einsum('bhnid,bhnjd->bhnij', kb, k) * decay, 0.0)
    eye = jnp.eye(C, dtype=jnp.float32)
    rhs = jnp.concatenate([v * beta[..., None], kb * jnp.exp(gc)[..., None]], axis=-1)
    sol = lax.linalg.triangular_solve(a_strict + eye, rhs, left_side=True, lower=True,
                                      unit_diagonal=True)
    u, w = sol[..., :Dv], sol[..., Dv:]
    attn_intra = jnp.einsum('bhnid,bhnjd->bhnij', q, k) * decay
    q_dec = q * jnp.exp(gc)[..., None]
    k_tail = k * jnp.exp(gc[..., -1:] - gc)[..., None]
    chunk_decay = jnp.exp(gc[..., -1])

    def step(state, xs):
        w_c, u_c, q_c, k_c, a_c, d_c = xs
        v_new = u_c - jnp.einsum('bhcd,bhde->bhce', w_c, state)
        o_c = jnp.einsum('bhcd,bhde->bhce', q_c, state) + jnp.einsum('bhij,bhje->bhie', a_c, v_new)
        state = state * d_c[..., None, None] + jnp.einsum('bhcd,bhce->bhde', k_c, v_new)
        return state, o_c

    xs = tuple(jnp.moveaxis(t, 2, 0) for t in (w, u, q_dec, k_tail, attn_intra, chunk_decay))
    state0 = jnp.zeros((B, H, Dk, Dv), dtype=jnp.float32)
    _, o = lax.scan(step, state0, xs)
    o = jnp.moveaxis(o, 0, 2).reshape(B, H, S, Dv)
    return jnp.moveaxis(o, 1, 2)


def setup_inputs(seed: int = 0) -> dict:
    key = jax.random.key(seed)
    ks = jax.random.split(key, 10)
    x = jax.random.normal(ks[0], (BATCH, SEQ, D_MODEL), dtype=jnp.float32)
    norm_g = 1.0 + 0.02 * jax.random.normal(ks[1], (DEPTH, D_MODEL), dtype=jnp.float32)
    w_in = jax.random.normal(ks[2], (DEPTH, D_MODEL, IN_WIDTH), dtype=jnp.float32) * D_MODEL ** -0.5
    conv_w = jax.random.normal(ks[3], (DEPTH, CONV_WIDTH, 3 * DN_WIDTH), dtype=jnp.float32) * CONV_WIDTH ** -0.5
    a_log = jnp.log(jax.random.uniform(ks[4], (DEPTH, DN_HEADS), minval=1.0, maxval=16.0))
    dt = jnp.exp(jax.random.uniform(ks[5], (DEPTH, DN_HEADS), minval=math.log(1e-3), maxval=math.log(1e-1)))
    dt_bias = dt + jnp.log(-jnp.expm1(-dt))
    dn_norm_g = 1.0 + 0.02 * jax.random.normal(ks[6], (DEPTH, HEAD_DIM), dtype=jnp.float32)
    w_out = jax.random.normal(ks[7], (DEPTH, MIX_WIDTH, D_MODEL), dtype=jnp.float32) * MIX_WIDTH ** -0.5
    final_norm_g = 1.0 + 0.02 * jax.random.normal(ks[8], (D_MODEL,), dtype=jnp.float32)
    return {"x": x, "norm_g": norm_g, "w_in": w_in, "conv_w": conv_w, "a_log": a_log,
            "dt_bias": dt_bias, "dn_norm_g": dn_norm_g, "w_out": w_out,
            "final_norm_g": final_norm_g}


def reference(x, norm_g, w_in, conv_w, a_log, dt_bias, dn_norm_g, w_out, final_norm_g):
    B, S, _ = x.shape
    slopes = alibi_slopes(ATTN_HEADS)
    h = x
    for layer in range(DEPTH):
        u = rms_norm(h, norm_g[layer])
        proj = u @ w_in[layer]
        aq, ak, av, ag, dq, dk, dv, dg, b_logit, a_logit = jnp.split(proj, IN_SPLITS, axis=-1)

        to_heads = lambda t: t.reshape(B, S, ATTN_HEADS, HEAD_DIM)
        qh, kh, vh = to_heads(aq), to_heads(ak), to_heads(av)
        outs, lses = [], []
        for window, dilation in DILATED_PATTERNS:
            o_p, lse_p = dilated_window_attention(qh, kh, vh, slopes, window, dilation)
            outs.append(o_p)
            lses.append(lse_p)
        mix_w = jax.nn.softmax(jnp.stack(lses, axis=0), axis=0)
        attn = jnp.einsum('pbsh,pbshd->bshd', mix_w, jnp.stack(outs, axis=0).astype(jnp.float32))
        attn = attn.reshape(B, S, ATTN_WIDTH).astype(x.dtype) * jax.nn.silu(ag)

        qkv = jax.nn.silu(causal_short_conv(jnp.concatenate([dq, dk, dv], axis=-1), conv_w[layer]))
        cq, ck, cv = jnp.split(qkv.astype(jnp.float32), 3, axis=-1)
        to_dn = lambda t: t.reshape(B, S, DN_HEADS, HEAD_DIM)
        q_dn = l2_normalize(to_dn(cq))
        k_dn = l2_normalize(to_dn(ck))
        v_dn = to_dn(cv)
        beta = jax.nn.sigmoid(b_logit.astype(jnp.float32))
        g = -jnp.exp(a_log[layer]) * jax.nn.softplus(a_logit.astype(jnp.float32) + dt_bias[layer])
        o_dn = gated_delta_rule(q_dn, k_dn, v_dn, beta, g)
        o_dn = rms_norm(o_dn, dn_norm_g[layer]).reshape(B, S, DN_WIDTH).astype(x.dtype) * jax.nn.silu(dg)

        mixed = jnp.concatenate([attn, o_dn], axis=-1)
        h = h + mixed @ w_out[layer]
    return rms_norm(h, final_norm_g)
```

```cpp
#include <hip/hip_runtime.h>
#include <hip/hip_cooperative_groups.h>
#include <cstdio>
namespace cg = cooperative_groups;

#ifndef MK_COOP
#define MK_COOP 1
#endif

namespace pg8 {
#define PG8_LAS __attribute__((address_space(3)))
typedef unsigned short bf16_t;
typedef short bf16x8 __attribute__((ext_vector_type(8)));
typedef float f32x4 __attribute__((ext_vector_type(4)));
typedef unsigned u32x4 __attribute__((ext_vector_type(4)));
constexpr int BM = 256, BK = 64, HALF = 128, HTB = HALF * BK * 2  , STAGE_BYTES = 8 * HTB, NXCD = 8, WGM = 8;

__host__ __device__ __forceinline__ int lds_byte(int r, int c) { const int st = (r >> 4) * 2 + (c >> 5), rr = r & 15, cc = c & 31, ob = rr * 64 + cc * 2; return st * 1024 + (ob ^ (((ob >> 9) & 1) << 5)); }
__host__ __device__ __forceinline__ void stage_rc(int b, int& R, int& C) { const int st = b / 1024, sb = b % 1024, swz = sb ^ (((sb >> 9) & 1) << 5); R = (st >> 1) * 16 + swz / 64; C = (st & 1) * 32 + (swz % 64) / 2; }
__host__ __device__ __forceinline__ int perm32(int rho) { const int n = rho >> 4, i = rho & 15; return 8 * (i >> 2) + 4 * n + (i & 3); }

struct Unit { int pm, pn; };
struct Gemm { const bf16_t* A; const bf16_t* Bt; int M, N, K; };

struct StaticOrder {
    int nM, nN, nwg, G, c;
    __host__ __device__ void init(int M, int N, int G_, int c_) { nM = M / BM; nN = N / BM; nwg = nM * nN; G = G_; c = c_; }
    __host__ __device__ bool next(int i, Unit& u) const {
        const long L = (long)i * G + c; if (L >= nwg) return false;
        int wgid = (int)L; { const int q = nwg / NXCD, r = nwg % NXCD, xcd = wgid % NXCD, off = wgid / NXCD; wgid = (xcd < r ? xcd * (q + 1) : r * (q + 1) + (xcd - r) * q) + off; }
        const int nig = WGM * nN, gid = wgid / nig, fm = gid * WGM, gsz = (nM - fm) < WGM ? (nM - fm) : WGM;
        u.pm = fm + ((wgid % nig) % gsz); u.pn = (wgid % nig) / gsz; return true;
    }
    __device__ __forceinline__ void a_ready(const Unit&) const {}
    __device__ __forceinline__ void done(const Unit&) const {}
};
template <class Epi, class Sched, bool STAMP = false>
__device__ __forceinline__ void gemm_phase(PG8_LAS unsigned char* lds, const Gemm g, const Sched& S, const Epi& E, unsigned long long* stamps) {
    const int tid = threadIdx.x, wid = __builtin_amdgcn_readfirstlane(tid >> 6), lane = tid & 63, wr = wid >> 2, wc = wid & 3, fr = lane & 15, fq = lane >> 4;
    const int K = g.K, nt = K / BK;
    int ts_lo = 0, ts_hi = 0, nts = 0; const unsigned long long rt_entry = STAMP ? (unsigned long long)wall_clock64() : 0ull;
#define PG8_STAMP() do { if (STAMP && wid == 0 && nts < 64) { const unsigned long long _c = (unsigned long long)clock64(); \
        ts_lo = (lane == nts) ? (int)(unsigned)_c : ts_lo; ts_hi = (lane == nts) ? (int)(unsigned)(_c >> 32) : ts_hi; ++nts; } } while (0)
    PG8_STAMP();
    unsigned voffA[2], voffB[2];
#pragma unroll
    for (int i = 0; i < 2; ++i) { int R, C; stage_rc(tid * 16 + i * 8192, R, C); const int Rb = Epi::PERM ? ((R & ~31) + perm32(R & 31)) : R;
        voffA[i] = (unsigned)(R * K + C) * 2u; voffB[i] = (unsigned)(Rb * K + C) * 2u; }
    const size_t kstep = (size_t)(BK * 2);
    const size_t hstep = (size_t)HALF * K * 2;
    const size_t tstep = 2 * hstep;
    const unsigned ldsw = (unsigned)wid * 1024u;
    const int aoff = lds_byte(wr * 64 + fr, fq * 8), boff = lds_byte(wc * 32 + fr, fq * 8);
#define PG8_SA(b, h) (((b) * 2 + (h)) * HTB)
#define PG8_SB(b, h) ((4 + (b) * 2 + (h)) * HTB)
#define PG8_STAGE(bufoff, gbase, voff) do { _Pragma("unroll") for (int _i = 0; _i < 2; ++_i) \
        __builtin_amdgcn_global_load_lds((const unsigned*)((const char*)(gbase) + (voff)[_i]), (PG8_LAS unsigned*)(lds + (bufoff) + ldsw + _i * 8192), 16, 0, 0); } while (0)
#define PG8_LDA(dst, b, h) do { _Pragma("unroll") for (int m = 0; m < 4; ++m) _Pragma("unroll") for (int k = 0; k < 2; ++k) dst[m][k] = *(const PG8_LAS bf16x8*)(lds + PG8_SA(b, h) + aoff + m * 2048 + k * 1024); } while (0)
#define PG8_LDB(dst, b, h) do { _Pragma("unroll") for (int n = 0; n < 2; ++n) _Pragma("unroll") for (int k = 0; k < 2; ++k) dst[n][k] = *(const PG8_LAS bf16x8*)(lds + PG8_SB(b, h) + boff + n * 2048 + k * 1024); } while (0)
#define PG8_MMA(ai, bj, At, Bt) do { __builtin_amdgcn_s_setprio(1); _Pragma("unroll") for (int m = 0; m < 4; ++m) _Pragma("unroll") for (int n = 0; n < 2; ++n) _Pragma("unroll") for (int k = 0; k < 2; ++k) \
        acc[ai][bj][m][n] = __builtin_amdgcn_mfma_f32_16x16x32_bf16(Bt[n][k], At[m][k], acc[ai][bj][m][n], 0, 0, 0); __builtin_amdgcn_s_setprio(0); } while (0)
#define PG8_WAIT_V(n) asm volatile("s_waitcnt vmcnt(" #n ")" ::: "memory")
#define PG8_WAIT_L(n) asm volatile("s_waitcnt lgkmcnt(" #n ")" ::: "memory")
#define PG8_BAR __builtin_amdgcn_s_barrier()
#define PG8_SCHED __builtin_amdgcn_sched_barrier(0)
    Unit cur, nxt; int ui = 0;
    if (!S.next(0, cur)) return;
    f32x4 acc[2][2][4][2];
#pragma unroll
    for (int a = 0; a < 2; ++a)
#pragma unroll
        for (int b = 0; b < 2; ++b)
#pragma unroll
            for (int m = 0; m < 4; ++m)
#pragma unroll
                for (int n = 0; n < 2; ++n) acc[a][b][m][n] = (f32x4){0.f, 0.f, 0.f, 0.f};
    bf16x8 At[4][2], B0[2][2], B1[2][2];
    const char* cA = (const char*)g.A + (size_t)cur.pm * tstep; const char* cB = (const char*)g.Bt + (size_t)cur.pn * tstep;
    S.a_ready(cur);
    PG8_STAGE(PG8_SB(0, 0), cB, voffB); PG8_STAGE(PG8_SA(0, 0), cA, voffA); PG8_STAGE(PG8_SB(0, 1), cB + hstep, voffB); PG8_STAGE(PG8_SA(0, 1), cA + hstep, voffA);
    if (wr == 1) PG8_BAR;
    PG8_WAIT_V(4); PG8_BAR;
    PG8_STAGE(PG8_SB(1, 0), cB + kstep, voffB); PG8_STAGE(PG8_SA(1, 0), cA + kstep, voffA); PG8_STAGE(PG8_SB(1, 1), cB + hstep + kstep, voffB);
    PG8_WAIT_V(6); PG8_BAR;
    PG8_STAMP();
    for (;;) {
        const bool has_next = S.next(ui + 1, nxt);
        const char* nA = has_next ? (const char*)g.A + (size_t)nxt.pm * tstep : cA; const char* nB = has_next ? (const char*)g.Bt + (size_t)nxt.pn * tstep : cB;
        for (int t = 0; t < nt; t += 2) {
            const bool last = (t == nt - 2);
            const char* a1 = cA + (size_t)(t + 1) * kstep;
            const char* a2 = last ? nA : cA + (size_t)(t + 2) * kstep; const char* b2 = last ? nB : cB + (size_t)(t + 2) * kstep;
            const char* a3 = a2 + kstep; const char* b3 = b2 + kstep;
            if (last && has_next) S.a_ready(nxt);
            PG8_LDB(B0, 0, 0); PG8_SCHED; PG8_LDA(At, 0, 0); PG8_STAGE(PG8_SA(1, 1), a1 + hstep, voffA);
            PG8_WAIT_L(8); PG8_BAR; PG8_WAIT_L(0); PG8_MMA(0, 0, At, B0); PG8_BAR; PG8_SCHED;
            PG8_LDB(B1, 0, 1); PG8_STAGE(PG8_SB(0, 0), b2, voffB);
            PG8_BAR; PG8_WAIT_L(0); PG8_MMA(0, 1, At, B1); PG8_BAR;
            PG8_LDA(At, 0, 1); PG8_STAGE(PG8_SA(0, 0), a2, voffA);
            PG8_BAR; PG8_WAIT_L(0); PG8_MMA(1, 0, At, B0); PG8_BAR; PG8_SCHED;
            PG8_STAGE(PG8_SB(0, 1), b2 + hstep, voffB);
            PG8_WAIT_V(6); PG8_BAR; PG8_MMA(1, 1, At, B1); PG8_BAR;
            PG8_LDB(B0, 1, 0); PG8_SCHED; PG8_LDA(At, 1, 0); PG8_STAGE(PG8_SA(0, 1), a2 + hstep, voffA);
            PG8_WAIT_L(8); PG8_BAR; PG8_WAIT_L(0); PG8_MMA(0, 0, At, B0); PG8_BAR; PG8_SCHED;
            PG8_LDB(B1, 1, 1); PG8_STAGE(PG8_SB(1, 0), b3, voffB);
            PG8_BAR; PG8_WAIT_L(0); PG8_MMA(0, 1, At, B1); PG8_BAR;
            PG8_LDA(At, 1, 1); PG8_STAGE(PG8_SA(1, 0), a3, voffA);
            PG8_BAR; PG8_WAIT_L(0); PG8_MMA(1, 0, At, B0); PG8_BAR; PG8_SCHED;
            PG8_STAGE(PG8_SB(1, 1), b3 + hstep, voffB);
            PG8_WAIT_V(6); PG8_BAR; PG8_MMA(1, 1, At, B1); PG8_BAR;
        }
        PG8_STAMP();
        if constexpr (!Epi::AFTER_DRAIN) { E(acc, cur, wr, wc, fr, fq); S.done(cur); }
        PG8_STAMP();
        if (!has_next) break;
#pragma unroll
        for (int a = 0; a < 2; ++a)
#pragma unroll
            for (int b = 0; b < 2; ++b)
#pragma unroll
                for (int m = 0; m < 4; ++m)
#pragma unroll
                    for (int n = 0; n < 2; ++n) acc[a][b][m][n] = (f32x4){0.f, 0.f, 0.f, 0.f};
        cur = nxt; cA = nA; cB = nB; ++ui;
    }
    PG8_WAIT_V(0);
    if (wr == 0) PG8_BAR;
    PG8_BAR;
    if constexpr (Epi::AFTER_DRAIN) { E.fused(acc, cur, wr, wc, fr, fq, lds, wid, lane); S.done(cur); }
    PG8_STAMP();
    if (STAMP && wid == 0) { stamps[lane] = lane < nts ? (((unsigned long long)(unsigned)ts_hi << 32) | (unsigned)ts_lo) : 0ull;
        if (lane == 62) stamps[62] = rt_entry; if (lane == 63) stamps[63] = (unsigned long long)wall_clock64(); }
#undef PG8_STAMP
#undef PG8_SA
#undef PG8_SB
#undef PG8_STAGE
#undef PG8_LDA
#undef PG8_LDB
#undef PG8_MMA
#undef PG8_WAIT_V
#undef PG8_WAIT_L
#undef PG8_BAR
#undef PG8_SCHED
}
}

#define LAS __attribute__((address_space(3)))
typedef unsigned short bf16_t;
typedef short bf16x8 __attribute__((ext_vector_type(8)));
typedef short bf16x4 __attribute__((ext_vector_type(4)));
typedef float f32x4 __attribute__((ext_vector_type(4)));
typedef unsigned u32x4 __attribute__((ext_vector_type(4)));
typedef unsigned u32x2 __attribute__((ext_vector_type(2)));

constexpr int T_TOK = 16384, DMODEL = 4096, SEQ = 8192, NPROJ = 16384, NIN = 16416, NPAD = 16640;
constexpr int LDS_BYTES = 131072;
constexpr size_t OFF_XN = 0, OFF_WINT = 134217728ull, OFF_WOUTT = 270532608ull, OFF_PROJ = 304087040ull, OFF_GATE = 840957952ull,
                 OFF_MIXED = 843055104ull, OFF_AB = 977272832ull, OFF_LSE = 1010827264ull, OFF_CD = 1013972992ull, WS_END = 1013989376ull;
constexpr size_t OFF_WB = 0, OFF_UB = 67108864ull, OFF_QD = 134217728ull, OFF_KT = 201326592ull;
constexpr size_t OUT_OP = 0, OUT_ODN = 201326592ull;

struct Params {
    const float* x; const float* norm_g; const float* w_in; const float* conv_w; const float* a_log; const float* dt_bias; const float* dn_norm_g; const float* w_out; const float* final_g;
    float* out; unsigned char* ws; int mask; int coop;
};

typedef __bf16 bf16v2_t __attribute__((ext_vector_type(2)));
typedef float f32v2_t __attribute__((ext_vector_type(2)));
__device__ __forceinline__ unsigned cvt_pk(float lo, float hi) { f32v2_t v = {lo, hi}; bf16v2_t b = __builtin_convertvector(v, bf16v2_t); return __builtin_bit_cast(unsigned, b); }
__device__ __forceinline__ float bflo(unsigned w) { return __uint_as_float(w << 16); }
__device__ __forceinline__ float bfhi(unsigned w) { return __uint_as_float(w & 0xffff0000u); }
__device__ __forceinline__ float bf2f(bf16_t v) { return __uint_as_float(((unsigned)v) << 16); }
__device__ __forceinline__ bf16_t f2bf(float f) { return (bf16_t)(cvt_pk(f, 0.f) & 0xffffu); }
__device__ __forceinline__ float silu_f(float v) { return v / (1.0f + __expf(-v)); }
__device__ __forceinline__ f32x4 mfma32(bf16x8 a, bf16x8 b, f32x4 c) { return __builtin_amdgcn_mfma_f32_16x16x32_bf16(a, b, c, 0, 0, 0); }
__device__ __forceinline__ f32x4 mfma16(bf16x4 a, bf16x4 b, f32x4 c) { return __builtin_amdgcn_mfma_f32_16x16x16bf16_1k(a, b, c, 0, 0, 0); }

struct EpiProj {
    static constexpr bool PERM = true, AFTER_DRAIN = false;
    bf16_t* O; float* gate;
    __device__ __forceinline__ void operator()(const f32x4 (&acc)[2][2][4][2], const pg8::Unit& u, int wr, int wc, int fr, int fq) const {
        const int row0 = u.pm * 256 + wr * 64 + fr;
        if (u.pn < 64) {
            const int col0 = u.pn * 256 + wc * 32 + 8 * fq;
#pragma unroll
            for (int ai = 0; ai < 2; ++ai)
#pragma unroll
                for (int m = 0; m < 4; ++m) { bf16_t* rowp = O + (size_t)(row0 + ai * 128 + m * 16) * NPROJ + col0;
#pragma unroll
                    for (int bj = 0; bj < 2; ++bj) { const f32x4 v0 = acc[ai][bj][m][0], v1 = acc[ai][bj][m][1];
                        u32x4 w; w.x = cvt_pk(v0[0], v0[1]); w.y = cvt_pk(v0[2], v0[3]); w.z = cvt_pk(v1[0], v1[1]); w.w = cvt_pk(v1[2], v1[3]);
                        *(u32x4*)(rowp + bj * 128) = w; } }
        } else if (wc == 0) {
#pragma unroll
            for (int ai = 0; ai < 2; ++ai)
#pragma unroll
                for (int m = 0; m < 4; ++m) { float* gp = gate + (size_t)(row0 + ai * 128 + m * 16) * 32 + 8 * fq;
                    *(f32x4*)gp = acc[ai][0][m][0]; *(f32x4*)(gp + 4) = acc[ai][0][m][1]; }
        }
    }
};
struct EpiResid {
    static constexpr bool PERM = false, AFTER_DRAIN = false;
    float* C; const float* X;
    __device__ __forceinline__ void operator()(const f32x4 (&acc)[2][2][4][2], const pg8::Unit& u, int wr, int wc, int fr, int fq) const {
        const int row0 = u.pm * 256 + wr * 64 + fr, col0 = u.pn * 256 + wc * 32 + 4 * fq;
#pragma unroll
        for (int ai = 0; ai < 2; ++ai)
#pragma unroll
            for (int m = 0; m < 4; ++m) { const size_t off = (size_t)(row0 + ai * 128 + m * 16) * DMODEL + col0;
#pragma unroll
                for (int bj = 0; bj < 2; ++bj)
#pragma unroll
                    for (int n = 0; n < 2; ++n) { const f32x4 xv = *(const f32x4*)(X + off + bj * 128 + n * 16); *(f32x4*)(C + off + bj * 128 + n * 16) = acc[ai][bj][m][n] + xv; } }
    }
};

__device__ __forceinline__ float wave_sum(float v) {
#pragma unroll
    for (int o = 32; o >= 1; o >>= 1) v += __shfl_xor(v, o);
    return v;
}
__device__ void phase_rmsnorm_x(const float* __restrict__ x, const float* __restrict__ g, bf16_t* __restrict__ xn) {
    const int wid = threadIdx.x >> 6, lane = threadIdx.x & 63;
    const int gw = blockIdx.x * 8 + wid, nw = gridDim.x * 8;
    for (int row = gw; row < T_TOK; row += nw) {
        const f32x4* xr = (const f32x4*)(x + (size_t)row * DMODEL);
        f32x4 v[16]; float ss = 0.f;
#pragma unroll
        for (int i = 0; i < 16; ++i) { v[i] = xr[i * 64 + lane]; ss += v[i][0] * v[i][0] + v[i][1] * v[i][1] + v[i][2] * v[i][2] + v[i][3] * v[i][3]; }
        ss = wave_sum(ss);
        const float rstd = rsqrtf(ss * (1.0f / DMODEL) + 1e-6f);
        bf16_t* orow = xn + (size_t)row * DMODEL;
#pragma unroll
        for (int i = 0; i < 16; ++i) { const f32x4 gg = ((const f32x4*)g)[i * 64 + lane]; u32x2 w; w.x = cvt_pk(v[i][0] * rstd * gg[0], v[i][1] * rstd * gg[1]); w.y = cvt_pk(v[i][2] * rstd * gg[2], v[i][3] * rstd * gg[3]);
            *(u32x2*)(orow + (i * 64 + lane) * 4) = w; }
    }
}
__device__ void phase_transpose(LAS unsigned char* lds, const float* __restrict__ W, int K, int N, int Npad, bf16_t* __restrict__ Wt) {
    const int wid = threadIdx.x >> 6, lane = threadIdx.x & 63;
    const int gw = blockIdx.x * 8 + wid, nw = gridDim.x * 8;
    const int nkt = K / 64, total = nkt * (Npad / 32);
    LAS bf16_t* tl = (LAS bf16_t*)(lds + wid * 4352);
    const int c4 = lane & 7, kr = lane >> 3, rn = lane >> 1, half = lane & 1;
    for (int tile = gw; tile < total; tile += nw) {
        const int nnt = Npad / 32, kt = tile / nnt, nt = tile - kt * nnt, n0 = nt * 32, k0 = kt * 64;
        const int n = n0 + 4 * c4;
#pragma unroll
        for (int it = 0; it < 8; ++it) { const int k = it * 8 + kr;
            f32x4 v = (f32x4){0.f, 0.f, 0.f, 0.f};
            if (n < N) v = *(const f32x4*)(W + (size_t)(k0 + k) * N + n);
            const unsigned p0 = cvt_pk(v[0], v[1]), p1 = cvt_pk(v[2], v[3]);
            tl[(4 * c4 + 0) * 66 + k] = (bf16_t)(p0 & 0xffffu); tl[(4 * c4 + 1) * 66 + k] = (bf16_t)(p0 >> 16);
            tl[(4 * c4 + 2) * 66 + k] = (bf16_t)(p1 & 0xffffu); tl[(4 * c4 + 3) * 66 + k] = (bf16_t)(p1 >> 16); }
        asm volatile("s_waitcnt lgkmcnt(0)" ::: "memory");
        __builtin_amdgcn_wave_barrier();
        const LAS unsigned* rp = (const LAS unsigned*)(tl + rn * 66 + 32 * half);
        unsigned d[16];
#pragma unroll
        for (int i = 0; i < 16; ++i) d[i] = rp[i];
        bf16_t* op = Wt + (size_t)(n0 + rn) * K + k0 + 32 * half;
#pragma unroll
        for (int i = 0; i < 4; ++i) *(u32x4*)(op + 8 * i) = (u32x4){d[4 * i], d[4 * i + 1], d[4 * i + 2], d[4 * i + 3]};
        asm volatile("s_waitcnt lgkmcnt(0)" ::: "memory");
        __builtin_amdgcn_wave_barrier();
    }
}

constexpr int N_ATTN_TASKS = 3 * 2 * 16 * 64;
__device__ void attn_task(LAS unsigned char* lds, const bf16_t* __restrict__ proj, bf16_t* __restrict__ op, float* __restrict__ lsep, int task) {
    const int tid = threadIdx.x, wid = tid >> 6, lane = tid & 63, fr = lane & 15, g = lane >> 4;
    const int p = task >> 11, rem = task & 2047, b = rem >> 10, h = (rem >> 6) & 15, idx = rem & 63;
    const int dsh = 2 * p, dil = 1 << dsh, nbp = 64 >> dsh;
    const int r = idx >> (6 - dsh), n = idx & (nbp - 1);
    const float slope = exp2f(-0.5f * (float)(h + 1));
    const int tb = b * SEQ + r;
#pragma unroll
    for (int i = 0; i < 8; ++i) {
        const int c = tid + 512 * i, j = c >> 4, ch = c & 15, idxk = (n - 1) * 128 + j;
        u32x4 kv = (u32x4){0u, 0u, 0u, 0u}, vv = (u32x4){0u, 0u, 0u, 0u};
        if (idxk >= 0) { const bf16_t* rowp = proj + (size_t)(tb + idxk * dil) * NPROJ + h * 128 + ch * 8; kv = *(const u32x4*)(rowp + 2048); vv = *(const u32x4*)(rowp + 4096); }
        *(LAS u32x4*)(lds + j * 256 + ((ch ^ (j & 15)) << 4)) = kv;
        *(LAS u32x4*)(lds + 65536 + j * 256 + ((ch ^ (((j >> 2) & 3) << 1)) << 4)) = vv;
    }
    const int tq = tb + (n * 128 + 16 * wid + fr) * dil;
    bf16x8 qf[4];
    { const bf16_t* qrow = proj + (size_t)tq * NPROJ + h * 128;
#pragma unroll
      for (int s = 0; s < 4; ++s) qf[s] = *(const bf16x8*)(qrow + 32 * s + 8 * g); }
    __syncthreads();
    float sc[9][4];
    float mx = -1e30f;
#pragma unroll
    for (int kt9 = 0; kt9 < 9; ++kt9) {
        const int kt = wid + kt9, jr = 16 * kt + fr;
        f32x4 acc = (f32x4){0.f, 0.f, 0.f, 0.f};
#pragma unroll
        for (int s = 0; s < 4; ++s) { const bf16x8 kf = *(const LAS bf16x8*)(lds + jr * 256 + (((4 * s + g) ^ fr) << 4)); acc = mfma32(kf, qf[s], acc); }
#pragma unroll
        for (int reg = 0; reg < 4; ++reg) { const int j = 16 * kt + 4 * g + reg, l = 16 * wid + fr, dist = l + 128 - j;
            const bool valid = (dist >= 0) && (dist <= 128) && (n > 0 || j >= 128);
            const float v = valid ? acc[reg] * 0.08838834764831845f - slope * (float)(dist * dil) : -1e30f;
            sc[kt9][reg] = v; mx = fmaxf(mx, v); }
    }
    mx = fmaxf(mx, __shfl_xor(mx, 16)); mx = fmaxf(mx, __shfl_xor(mx, 32));
    float sum = 0.f;
    bf16x4 pk[9];
#pragma unroll
    for (int kt9 = 0; kt9 < 9; ++kt9) {
        float e[4];
#pragma unroll
        for (int reg = 0; reg < 4; ++reg) { e[reg] = __expf(sc[kt9][reg] - mx); sum += e[reg]; }
        u32x2 w; w.x = cvt_pk(e[0], e[1]); w.y = cvt_pk(e[2], e[3]);
        pk[kt9] = __builtin_bit_cast(bf16x4, w);
    }
    sum += __shfl_xor(sum, 16); sum += __shfl_xor(sum, 32);
    const float inv = 1.0f / sum, lse = mx + __logf(sum);
    bf16_t* orow = op + ((size_t)p * T_TOK + tq) * 2048 + h * 128;
#pragma unroll
    for (int dt = 0; dt < 8; ++dt) {
        f32x4 acc = (f32x4){0.f, 0.f, 0.f, 0.f};
        const int d = 16 * dt + fr;
        const int voff = 65536 + ((((d >> 3) ^ (g << 1))) << 4) + (d & 7) * 2;
#pragma unroll
        for (int kt9 = 0; kt9 < 9; ++kt9) {
            const int key0 = 16 * (wid + kt9) + 4 * g;
            bf16x4 vf;
#pragma unroll
            for (int i = 0; i < 4; ++i) vf[i] = *(const LAS short*)(lds + voff + (key0 + i) * 256);
            acc = mfma16(vf, pk[kt9], acc);
        }
        u32x2 w; w.x = cvt_pk(acc[0] * inv, acc[1] * inv); w.y = cvt_pk(acc[2] * inv, acc[3] * inv);
        *(u32x2*)(orow + 16 * dt + 4 * g) = w;
    }
    if (g == 0) lsep[((size_t)p * T_TOK + tq) * 16 + h] = lse;
    __syncthreads();
}

constexpr int DN_Q = 0, DN_K = 17408, DN_V = 34816, DN_A = 52224, DN_GC = 68608, DN_BETA = 68864, DN_EG = 69120;
__device__ void dn_prep_chunk(LAS unsigned char* lds, const bf16_t* __restrict__ proj, const float* __restrict__ gate, const float* __restrict__ conv_w, const float* __restrict__ a_log, const float* __restrict__ dt_bias,
                              bf16_t* __restrict__ Wb, bf16_t* __restrict__ Ub, bf16_t* __restrict__ Qd, bf16_t* __restrict__ Kt, bf16_t* __restrict__ Ab, float* __restrict__ Cd, int chunk) {
    const int tid = threadIdx.x, wid = tid >> 6, lane = tid & 63, fr = lane & 15, g = lane >> 4;
    const int bh = chunk >> 7, n = chunk & 127, b = bh >> 4, h = bh & 15;
    const int s0 = n * 64; const size_t t0 = (size_t)b * SEQ + s0;
    LAS float* A_s = (LAS float*)(lds + DN_A); LAS float* gc_s = (LAS float*)(lds + DN_GC); LAS float* beta_s = (LAS float*)(lds + DN_BETA); LAS float* eg_s = (LAS float*)(lds + DN_EG);
    {
        const int i = tid >> 3, cg8 = tid & 7;
#pragma unroll
        for (int X = 0; X < 3; ++X) {
            float y[16];
#pragma unroll
            for (int hf = 0; hf < 2; ++hf) {
                float acc[8];
#pragma unroll
                for (int e = 0; e < 8; ++e) acc[e] = 0.f;
                const int cb = X * 2048 + h * 128 + 16 * cg8 + 8 * hf;
#pragma unroll
                for (int j = 0; j < 4; ++j) { const int sp = s0 + i - 3 + j;
                    if (sp >= 0) { const u32x4 xv = *(const u32x4*)(proj + ((size_t)b * SEQ + sp) * NPROJ + 8192 + cb);
                        const f32x4 w0 = *(const f32x4*)(conv_w + j * 6144 + cb), w1 = *(const f32x4*)(conv_w + j * 6144 + cb + 4);
                        acc[0] += w0[0] * bflo(xv.x); acc[1] += w0[1] * bfhi(xv.x); acc[2] += w0[2] * bflo(xv.y); acc[3] += w0[3] * bfhi(xv.y);
                        acc[4] += w1[0] * bflo(xv.z); acc[5] += w1[1] * bfhi(xv.z); acc[6] += w1[2] * bflo(xv.w); acc[7] += w1[3] * bfhi(xv.w); } }
#pragma unroll
                for (int e = 0; e < 8; ++e) y[hf * 8 + e] = silu_f(acc[e]);
            }
            if (X < 2) { float ss = 0.f;
#pragma unroll
                for (int e = 0; e < 16; ++e) ss += y[e] * y[e];
                ss += __shfl_xor(ss, 1); ss += __shfl_xor(ss, 2); ss += __shfl_xor(ss, 4);
                const float scl = rsqrtf(ss + 1e-6f) * (X == 0 ? 0.08838834764831845f : 1.0f);
#pragma unroll
                for (int e = 0; e < 16; ++e) y[e] *= scl; }
            LAS u32x4* dst = (LAS u32x4*)(lds + X * 17408 + i * 272 + cg8 * 32);
            dst[0] = (u32x4){cvt_pk(y[0], y[1]), cvt_pk(y[2], y[3]), cvt_pk(y[4], y[5]), cvt_pk(y[6], y[7])};
            dst[1] = (u32x4){cvt_pk(y[8], y[9]), cvt_pk(y[10], y[11]), cvt_pk(y[12], y[13]), cvt_pk(y[14], y[15])};
        }
    }
    if (wid == 0) {
        const float bl = gate[(t0 + lane) * 32 + h], al = gate[(t0 + lane) * 32 + 16 + h];
        const float beta = 1.0f / (1.0f + expf(-bl));
        const float xx = al + dt_bias[h];
        const float sp = xx > 20.f ? xx : log1pf(expf(xx));
        float gc = -expf(a_log[h]) * sp;
#pragma unroll
        for (int off = 1; off < 64; off <<= 1) { const float v = __shfl_up(gc, off); if (lane >= off) gc += v; }
        gc_s[lane] = gc; beta_s[lane] = beta; eg_s[lane] = expf(gc);
    }
    __syncthreads();
    {
        const int type = wid >> 2, ti = wid & 3;
#pragma unroll
        for (int tj = 0; tj < 4; ++tj) {
            if (tj > ti) { if (type == 1) *(u32x2*)(Ab + (size_t)chunk * 4096 + (16 * ti + fr) * 64 + 16 * tj + 4 * g) = (u32x2){0u, 0u}; continue; }
            f32x4 acc = (f32x4){0.f, 0.f, 0.f, 0.f};
            if (type == 0) {
#pragma unroll
                for (int s = 0; s < 4; ++s) { const bf16x8 a = *(const LAS bf16x8*)(lds + DN_K + (16 * ti + fr) * 272 + (32 * s + 8 * g) * 2), bb = *(const LAS bf16x8*)(lds + DN_K + (16 * tj + fr) * 272 + (32 * s + 8 * g) * 2); acc = mfma32(a, bb, acc); }
                const int j = 16 * tj + fr; const float gj = gc_s[j];
#pragma unroll
                for (int reg = 0; reg < 4; ++reg) { const int i = 16 * ti + 4 * g + reg; const float e = __expf(fminf(gc_s[i] - gj, 0.f));
                    A_s[i * 64 + j] = (i > j) ? beta_s[i] * acc[reg] * e : 0.f; }
            } else {
#pragma unroll
                for (int s = 0; s < 4; ++s) { const bf16x8 a = *(const LAS bf16x8*)(lds + DN_K + (16 * tj + fr) * 272 + (32 * s + 8 * g) * 2), bb = *(const LAS bf16x8*)(lds + DN_Q + (16 * ti + fr) * 272 + (32 * s + 8 * g) * 2); acc = mfma32(a, bb, acc); }
                const int i = 16 * ti + fr; const float gi = gc_s[i]; float v[4];
#pragma unroll
                for (int reg = 0; reg < 4; ++reg) { const int j = 16 * tj + 4 * g + reg; const float e = __expf(fminf(gi - gc_s[j], 0.f)); v[reg] = (i >= j) ? acc[reg] * e : 0.f; }
                *(u32x2*)(Ab + (size_t)chunk * 4096 + i * 64 + 16 * tj + 4 * g) = (u32x2){cvt_pk(v[0], v[1]), cvt_pk(v[2], v[3])};
            }
        }
    }
    __syncthreads();
    if (wid < 4) {
        const int c = tid, cc = c & 127; const bool isu = c < 128;
        const LAS bf16_t* src = (const LAS bf16_t*)(lds + (isu ? DN_V : DN_K)) + cc;
        bf16_t* dst = (isu ? Ub : Wb) + (size_t)chunk * 8192 + cc;
        float xs[64];
#pragma unroll
        for (int i = 0; i < 64; ++i) {
            float acc = bf2f(src[i * 136]) * beta_s[i]; if (!isu) acc *= eg_s[i];
#pragma unroll
            for (int jj = 0; jj < (i + 3) / 4; ++jj) { const f32x4 a4 = *(const LAS f32x4*)(A_s + i * 64 + 4 * jj);
#pragma unroll
                for (int e = 0; e < 4; ++e) if (4 * jj + e < i) acc -= a4[e] * xs[4 * jj + e]; }
            xs[i] = acc;
            dst[i * 128] = f2bf(acc);
        }
    } else {
        const int t2 = tid - 256;
        { const int i = t2 >> 2, part = t2 & 3; const float e = eg_s[i];
#pragma unroll
          for (int c4 = 0; c4 < 4; ++c4) { const u32x4 qv = *(const LAS u32x4*)(lds + DN_Q + i * 272 + part * 64 + c4 * 16);
              u32x4 o; o.x = cvt_pk(bflo(qv.x) * e, bfhi(qv.x) * e); o.y = cvt_pk(bflo(qv.y) * e, bfhi(qv.y) * e); o.z = cvt_pk(bflo(qv.z) * e, bfhi(qv.z) * e); o.w = cvt_pk(bflo(qv.w) * e, bfhi(qv.w) * e);
              *(u32x4*)(Qd + (size_t)chunk * 8192 + i * 128 + part * 32 + c4 * 8) = o; } }
        { const int d = t2 & 127, ih = t2 >> 7; const float gl = gc_s[63]; const LAS bf16_t* ks = (const LAS bf16_t*)(lds + DN_K) + d;
#pragma unroll
          for (int i8 = 0; i8 < 4; ++i8) { float v[8];
#pragma unroll
              for (int e = 0; e < 8; ++e) { const int i = 32 * ih + 8 * i8 + e; v[e] = bf2f(ks[i * 136]) * __expf(gl - gc_s[i]); }
              *(u32x4*)(Kt + (size_t)chunk * 8192 + d * 64 + 32 * ih + 8 * i8) = (u32x4){cvt_pk(v[0], v[1]), cvt_pk(v[2], v[3]), cvt_pk(v[4], v[5]), cvt_pk(v[6], v[7])}; } }
        if (t2 == 0) Cd[chunk] = expf(gc_s[63]);
    }
    __syncthreads();
}

struct ScanRegs { bf16x8 wf[4], qf[4], af[2], kf[2]; float uv[4]; float cd; };
__device__ __forceinline__ void scan_load(ScanRegs& R, const bf16_t* __restrict__ Wb, const bf16_t* __restrict__ Ub, const bf16_t* __restrict__ Qd, const bf16_t* __restrict__ Kt, const bf16_t* __restrict__ Ab, const float* __restrict__ Cd,
                                          int chunk, int wid, int fr, int g, int sl) {
    if (wid < 4) {
        const size_t ro = (size_t)chunk * 8192 + (16 * wid + fr) * 128 + 8 * g;
#pragma unroll
        for (int s = 0; s < 4; ++s) { R.wf[s] = *(const bf16x8*)(Wb + ro + 32 * s); R.qf[s] = *(const bf16x8*)(Qd + ro + 32 * s); }
#pragma unroll
        for (int s = 0; s < 2; ++s) R.af[s] = *(const bf16x8*)(Ab + (size_t)chunk * 4096 + (16 * wid + fr) * 64 + 32 * s + 8 * g);
#pragma unroll
        for (int reg = 0; reg < 4; ++reg) R.uv[reg] = bf2f(Ub[(size_t)chunk * 8192 + (16 * wid + 4 * g + reg) * 128 + 16 * sl + fr]);
    }
#pragma unroll
    for (int s = 0; s < 2; ++s) R.kf[s] = *(const bf16x8*)(Kt + (size_t)chunk * 8192 + (16 * wid + fr) * 64 + 32 * s + 8 * g);
    R.cd = Cd[chunk];
}
__device__ __forceinline__ void scan_step(LAS unsigned char* lds, const ScanRegs& R, f32x4& Sacc, bf16_t* __restrict__ orow  , int wid, int fr, int g) {
    f32x4 acc2 = (f32x4){0.f, 0.f, 0.f, 0.f};
    if (wid < 4) {
        f32x4 acc1 = (f32x4){0.f, 0.f, 0.f, 0.f};
#pragma unroll
        for (int s = 0; s < 4; ++s) { const bf16x8 sf = *(const LAS bf16x8*)(lds + fr * 272 + (32 * s + 8 * g) * 2); acc1 = mfma32(R.wf[s], sf, acc1); acc2 = mfma32(R.qf[s], sf, acc2); }
        *(LAS u32x2*)(lds + 4352 + fr * 144 + (16 * wid + 4 * g) * 2) = (u32x2){cvt_pk(R.uv[0] - acc1[0], R.uv[1] - acc1[1]), cvt_pk(R.uv[2] - acc1[2], R.uv[3] - acc1[3])};
    }
    __syncthreads();
    const bf16x8 v0 = *(const LAS bf16x8*)(lds + 4352 + fr * 144 + (8 * g) * 2), v1 = *(const LAS bf16x8*)(lds + 4352 + fr * 144 + (32 + 8 * g) * 2);
    Sacc = Sacc * R.cd;
    Sacc = mfma32(R.kf[0], v0, Sacc); Sacc = mfma32(R.kf[1], v1, Sacc);
    *(LAS u32x2*)(lds + fr * 272 + (16 * wid + 4 * g) * 2) = (u32x2){cvt_pk(Sacc[0], Sacc[1]), cvt_pk(Sacc[2], Sacc[3])};
    if (wid < 4) {
        acc2 = mfma32(R.af[0], v0, acc2); acc2 = mfma32(R.af[1], v1, acc2);
#pragma unroll
        for (int reg = 0; reg < 4; ++reg) orow[(size_t)(16 * wid + 4 * g + reg) * 2048] = f2bf(acc2[reg]);
    }
    __syncthreads();
}
__device__ void dn_scan_item(LAS unsigned char* lds, const bf16_t* __restrict__ Wb, const bf16_t* __restrict__ Ub, const bf16_t* __restrict__ Qd, const bf16_t* __restrict__ Kt, const bf16_t* __restrict__ Ab, const float* __restrict__ Cd,
                             bf16_t* __restrict__ Odn, int item) {
    const int tid = threadIdx.x, wid = tid >> 6, lane = tid & 63, fr = lane & 15, g = lane >> 4;
    const int bh = (item & 7) + 8 * (item >> 6), sl = (item >> 3) & 7, b = bh >> 4, h = bh & 15;
    f32x4 Sacc = (f32x4){0.f, 0.f, 0.f, 0.f};
    *(LAS u32x2*)(lds + fr * 272 + (16 * wid + 4 * g) * 2) = (u32x2){0u, 0u};
    __syncthreads();
    const int c0 = bh * 128;
    bf16_t* obase = Odn + ((size_t)b * SEQ) * 2048 + h * 128 + 16 * sl + fr;
    ScanRegs RA, RB, RC;
    scan_load(RA, Wb, Ub, Qd, Kt, Ab, Cd, c0, wid, fr, g, sl);
    scan_load(RB, Wb, Ub, Qd, Kt, Ab, Cd, c0 + 1, wid, fr, g, sl);
    for (int n = 0; n < 129; n += 3) {
        if (n + 2 < 128) scan_load(RC, Wb, Ub, Qd, Kt, Ab, Cd, c0 + n + 2, wid, fr, g, sl);
        scan_step(lds, RA, Sacc, obase + (size_t)(n * 64) * 2048, wid, fr, g);
        if (n + 1 < 128) { if (n + 3 < 128) scan_load(RA, Wb, Ub, Qd, Kt, Ab, Cd, c0 + n + 3, wid, fr, g, sl);
            scan_step(lds, RB, Sacc, obase + (size_t)((n + 1) * 64) * 2048, wid, fr, g); }
        if (n + 2 < 128) { if (n + 4 < 128) scan_load(RB, Wb, Ub, Qd, Kt, Ab, Cd, c0 + n + 4, wid, fr, g, sl);
            scan_step(lds, RC, Sacc, obase + (size_t)((n + 2) * 64) * 2048, wid, fr, g); }
    }
    __syncthreads();
}

__device__ void phase_finalize(const bf16_t* __restrict__ proj, const bf16_t* __restrict__ op, const float* __restrict__ lsep, const bf16_t* __restrict__ Odn, const float* __restrict__ dn_g, bf16_t* __restrict__ mixed) {
    const int tid = threadIdx.x, sub = tid & 15;
    f32x4 g0 = *(const f32x4*)(dn_g + sub * 8), g1 = *(const f32x4*)(dn_g + sub * 8 + 4);
    for (int base = blockIdx.x * 32; base < T_TOK * 16; base += gridDim.x * 32) {
        const int pi = base + (tid >> 4), t = pi >> 4, h = pi & 15;
        { const float l0 = lsep[((size_t)0 * T_TOK + t) * 16 + h], l1 = lsep[((size_t)1 * T_TOK + t) * 16 + h], l2 = lsep[((size_t)2 * T_TOK + t) * 16 + h];
          const float m = fmaxf(l0, fmaxf(l1, l2)); float e0 = __expf(l0 - m), e1 = __expf(l1 - m), e2 = __expf(l2 - m); const float inv = 1.0f / (e0 + e1 + e2); e0 *= inv; e1 *= inv; e2 *= inv;
          const size_t oo = (size_t)t * 2048 + h * 128 + sub * 8;
          const u32x4 a0 = *(const u32x4*)(op + oo), a1 = *(const u32x4*)(op + (size_t)T_TOK * 2048 + oo), a2 = *(const u32x4*)(op + (size_t)2 * T_TOK * 2048 + oo);
          const u32x4 gt = *(const u32x4*)(proj + (size_t)t * NPROJ + 6144 + h * 128 + sub * 8);
          u32x4 o;
#define MIXW(F) { const float lo = (e0 * bflo(a0.F) + e1 * bflo(a1.F) + e2 * bflo(a2.F)) * silu_f(bflo(gt.F)), hi = (e0 * bfhi(a0.F) + e1 * bfhi(a1.F) + e2 * bfhi(a2.F)) * silu_f(bfhi(gt.F)); o.F = cvt_pk(lo, hi); }
          MIXW(x) MIXW(y) MIXW(z) MIXW(w)
#undef MIXW
          *(u32x4*)(mixed + (size_t)t * DMODEL + h * 128 + sub * 8) = o; }
        { const u32x4 ov = *(const u32x4*)(Odn + (size_t)t * 2048 + h * 128 + sub * 8);
          float v[8] = {bflo(ov.x), bfhi(ov.x), bflo(ov.y), bfhi(ov.y), bflo(ov.z), bfhi(ov.z), bflo(ov.w), bfhi(ov.w)};
          float ss = 0.f;
#pragma unroll
          for (int e = 0; e < 8; ++e) ss += v[e] * v[e];
          ss += __shfl_xor(ss, 1); ss += __shfl_xor(ss, 2); ss += __shfl_xor(ss, 4); ss += __shfl_xor(ss, 8);
          const float rstd = rsqrtf(ss * (1.0f / 128.0f) + 1e-6f);
          const u32x4 gt = *(const u32x4*)(proj + (size_t)t * NPROJ + 14336 + h * 128 + sub * 8);
          u32x4 o;
          o.x = cvt_pk(v[0] * rstd * g0[0] * silu_f(bflo(gt.x)), v[1] * rstd * g0[1] * silu_f(bfhi(gt.x)));
          o.y = cvt_pk(v[2] * rstd * g0[2] * silu_f(bflo(gt.y)), v[3] * rstd * g0[3] * silu_f(bfhi(gt.y)));
          o.z = cvt_pk(v[4] * rstd * g1[0] * silu_f(bflo(gt.z)), v[5] * rstd * g1[1] * silu_f(bfhi(gt.z)));
          o.w = cvt_pk(v[6] * rstd * g1[2] * silu_f(bflo(gt.w)), v[7] * rstd * g1[3] * silu_f(bfhi(gt.w)));
          *(u32x4*)(mixed + (size_t)t * DMODEL + 2048 + h * 128 + sub * 8) = o; }
    }
}

__device__ void phase_final_norm(float* __restrict__ out, const float* __restrict__ g) {
    const int wid = threadIdx.x >> 6, lane = threadIdx.x & 63;
    const int gw = blockIdx.x * 8 + wid, nw = gridDim.x * 8;
    for (int row = gw; row < T_TOK; row += nw) {
        f32x4* xr = (f32x4*)(out + (size_t)row * DMODEL);
        f32x4 v[16]; float ss = 0.f;
#pragma unroll
        for (int i = 0; i < 16; ++i) { v[i] = xr[i * 64 + lane]; ss += v[i][0] * v[i][0] + v[i][1] * v[i][1] + v[i][2] * v[i][2] + v[i][3] * v[i][3]; }
        ss = wave_sum(ss);
        const float rstd = rsqrtf(ss * (1.0f / DMODEL) + 1e-6f);
#pragma unroll
        for (int i = 0; i < 16; ++i) { const f32x4 gg = ((const f32x4*)g)[i * 64 + lane]; xr[i * 64 + lane] = v[i] * rstd * gg; }
    }
}

__global__ void __launch_bounds__(512, 2) mega_fwd(Params p) {
    extern __shared__ __attribute__((aligned(16))) unsigned char shm[];
    LAS unsigned char* lds = (LAS unsigned char*)shm;
    cg::grid_group grid = cg::this_grid();
    unsigned char* ws = p.ws;
    bf16_t* xn = (bf16_t*)(ws + OFF_XN); bf16_t* WinT = (bf16_t*)(ws + OFF_WINT); bf16_t* WoutT = (bf16_t*)(ws + OFF_WOUTT); bf16_t* proj = (bf16_t*)(ws + OFF_PROJ);
    float* gate = (float*)(ws + OFF_GATE); bf16_t* mixed = (bf16_t*)(ws + OFF_MIXED); bf16_t* Ab = (bf16_t*)(ws + OFF_AB); float* lsep = (float*)(ws + OFF_LSE); float* Cd = (float*)(ws + OFF_CD);
    bf16_t* Wb = (bf16_t*)(ws + OFF_WB); bf16_t* Ub = (bf16_t*)(ws + OFF_UB); bf16_t* Qd = (bf16_t*)(ws + OFF_QD); bf16_t* Kt = (bf16_t*)(ws + OFF_KT);
    bf16_t* op = (bf16_t*)((unsigned char*)p.out + OUT_OP); bf16_t* Odn = (bf16_t*)((unsigned char*)p.out + OUT_ODN);
    const int G = (int)gridDim.x, c = (int)blockIdx.x;

    if (p.mask & 1) {
        phase_rmsnorm_x(p.x, p.norm_g, xn);
        phase_transpose(lds, p.w_in, DMODEL, NIN, NPAD, WinT);
        phase_transpose(lds, p.w_out, DMODEL, DMODEL, DMODEL, WoutT);
    }
    if (p.coop) grid.sync();
    if (p.mask & 2) {
        __syncthreads();
        pg8::Gemm g{xn, WinT, T_TOK, NPAD, DMODEL}; pg8::StaticOrder S; S.init(T_TOK, NPAD, G, c); EpiProj E{proj, gate};
        pg8::gemm_phase<EpiProj, pg8::StaticOrder, false>(lds, g, S, E, nullptr);
        __syncthreads();
    }
    if (p.coop) grid.sync();
    if (p.mask & 4) {
        for (int task = c; task < N_ATTN_TASKS; task += G) attn_task(lds, proj, op, lsep, task);
        for (int chunk = c; chunk < 4096; chunk += G) dn_prep_chunk(lds, proj, gate, p.conv_w, p.a_log, p.dt_bias, Wb, Ub, Qd, Kt, Ab, Cd, chunk);
    }
    if (p.coop) grid.sync();
    if (p.mask & 8) {
        for (int item = c; item < 256; item += G) dn_scan_item(lds, Wb, Ub, Qd, Kt, Ab, Cd, Odn, item);
    }
    if (p.coop) grid.sync();
    if (p.mask & 16) phase_finalize(proj, op, lsep, Odn, p.dn_norm_g, mixed);
    if (p.coop) grid.sync();
    if (p.mask & 32) {
        __syncthreads();
        pg8::Gemm g{mixed, WoutT, T_TOK, DMODEL, DMODEL}; pg8::StaticOrder S; S.init(T_TOK, DMODEL, G, c); EpiResid E{p.out, p.x};
        pg8::gemm_phase<EpiResid, pg8::StaticOrder, false>(lds, g, S, E, nullptr);
        __syncthreads();
    }
    if (p.coop) grid.sync();
    if (p.mask & 64) phase_final_norm(p.out, p.final_g);
}

extern "C" void kernel_launch(void* const* d_in, const int* in_sizes, int n_in, void* d_out, int out_size, void* d_ws, size_t ws_size, hipStream_t stream) {
    static int grid = 0;
    if (grid == 0) {
        if (n_in != 9 || out_size != T_TOK * DMODEL || ws_size < WS_END) { fprintf(stderr, "kernel_launch: unexpected shapes (n_in %d out %d ws %zu)\n", n_in, out_size, ws_size); grid = -1; return; }
        int dev = 0, cus = 0, per_cu = 0;
        hipGetDevice(&dev); hipDeviceGetAttribute(&cus, hipDeviceAttributeMultiprocessorCount, dev);
        if (hipFuncSetAttribute((const void*)mega_fwd, hipFuncAttributeMaxDynamicSharedMemorySize, LDS_BYTES) != hipSuccess) { fprintf(stderr, "kernel_launch: hipFuncSetAttribute failed\n"); grid = -1; return; }
        if (hipOccupancyMaxActiveBlocksPerMultiprocessor(&per_cu, (const void*)mega_fwd, 512, LDS_BYTES) != hipSuccess || per_cu < 1) { fprintf(stderr, "kernel_launch: occupancy query gives %d\n", per_cu); per_cu = 1; }
        (void)hipGetLastError();
        grid = cus * 1;
    }
    if (grid < 0) return;
    Params p{};
    p.x = (const float*)d_in[0]; p.norm_g = (const float*)d_in[1]; p.w_in = (const float*)d_in[2]; p.conv_w = (const float*)d_in[3]; p.a_log = (const float*)d_in[4];
    p.dt_bias = (const float*)d_in[5]; p.dn_norm_g = (const float*)d_in[6]; p.w_out = (const float*)d_in[7]; p.final_g = (const float*)d_in[8];
    p.out = (float*)d_out; p.ws = (unsigned char*)d_ws;
#if MK_COOP
    p.mask = 127; p.coop = 1;
    void* args[] = {&p};
    hipError_t e = hipLaunchCooperativeKernel((const void*)mega_fwd, dim3(grid), dim3(512), args, LDS_BYTES, stream);
    if (e != hipSuccess) fprintf(stderr, "cooperative launch failed: %s (grid %d)\n", hipGetErrorString(e), grid);
#else
    p.coop = 0;
    for (int ph = 0; ph < 7; ++ph) { p.mask = 1 << ph; hipLaunchKernelGGL(mega_fwd, dim3(grid), dim3(512), LDS_BYTES, stream, p); }
#endif
}
```

```cpp
#include <hip/hip_runtime.h>
#include <hip/hip_cooperative_groups.h>
#include <cstdio>
namespace cg = cooperative_groups;

#ifndef MK_COOP
#define MK_COOP 1
#endif

#ifndef REP_P0
#define REP_P0 1
#endif
#ifndef REP_G1
#define REP_G1 1
#endif
#ifndef REP_ATT
#define REP_ATT 1
#endif
#ifndef REP_PREP
#define REP_PREP 1
#endif
#ifndef REP_SCAN
#define REP_SCAN 1
#endif
#ifndef REP_FIN
#define REP_FIN 1
#endif
namespace pg8 {
#define PG8_LAS __attribute__((address_space(3)))
typedef unsigned short bf16_t;
typedef short bf16x8 __attribute__((ext_vector_type(8)));
typedef float f32x4 __attribute__((ext_vector_type(4)));
typedef unsigned u32x4 __attribute__((ext_vector_type(4)));
constexpr int BM = 256, BK = 64, HALF = 128, HTB = HALF * BK * 2  , STAGE_BYTES = 8 * HTB, NXCD = 8, WGM = 8;

__host__ __device__ __forceinline__ int lds_byte(int r, int c) { const int st = (r >> 4) * 2 + (c >> 5), rr = r & 15, cc = c & 31, ob = rr * 64 + cc * 2; return st * 1024 + (ob ^ (((ob >> 9) & 1) << 5)); }
__host__ __device__ __forceinline__ void stage_rc(int b, int& R, int& C) { const int st = b / 1024, sb = b % 1024, swz = sb ^ (((sb >> 9) & 1) << 5); R = (st >> 1) * 16 + swz / 64; C = (st & 1) * 32 + (swz % 64) / 2; }
__host__ __device__ __forceinline__ int perm32(int rho) { const int n = rho >> 4, i = rho & 15; return 8 * (i >> 2) + 4 * n + (i & 3); }

struct Unit { int pm, pn; };
struct Gemm { const bf16_t* A; const bf16_t* Bt; int M, N, K; };

struct StaticOrder {
    int nM, nN, nwg, G, c;
    __host__ __device__ void init(int M, int N, int G_, int c_) { nM = M / BM; nN = N / BM; nwg = nM * nN; G = G_; c = c_; }
    __host__ __device__ bool next(int i, Unit& u) const {
        const long L = (long)i * G + c; if (L >= nwg) return false;
        int wgid = (int)L; { const int q = nwg / NXCD, r = nwg % NXCD, xcd = wgid % NXCD, off = wgid / NXCD; wgid = (xcd < r ? xcd * (q + 1) : r * (q + 1) + (xcd - r) * q) + off; }
        const int nig = WGM * nN, gid = wgid / nig, fm = gid * WGM, gsz = (nM - fm) < WGM ? (nM - fm) : WGM;
        u.pm = fm + ((wgid % nig) % gsz); u.pn = (wgid % nig) / gsz; return true;
    }
    __device__ __forceinline__ void a_ready(const Unit&) const {}
    __device__ __forceinline__ void done(const Unit&) const {}
};
template <class Epi, class Sched, bool STAMP = false>
__device__ __forceinline__ void gemm_phase(PG8_LAS unsigned char* lds, const Gemm g, const Sched& S, const Epi& E, unsigned long long* stamps) {
    const int tid = threadIdx.x, wid = __builtin_amdgcn_readfirstlane(tid >> 6), lane = tid & 63, wr = wid >> 2, wc = wid & 3, fr = lane & 15, fq = lane >> 4;
    const int K = g.K, nt = K / BK;
    int ts_lo = 0, ts_hi = 0, nts = 0; const unsigned long long rt_entry = STAMP ? (unsigned long long)wall_clock64() : 0ull;
#define PG8_STAMP() do { if (STAMP && wid == 0 && nts < 64) { const unsigned long long _c = (unsigned long long)clock64(); \
        ts_lo = (lane == nts) ? (int)(unsigned)_c : ts_lo; ts_hi = (lane == nts) ? (int)(unsigned)(_c >> 32) : ts_hi; ++nts; } } while (0)
    PG8_STAMP();
    unsigned voffA[2], voffB[2];
#pragma unroll
    for (int i = 0; i < 2; ++i) { int R, C; stage_rc(tid * 16 + i * 8192, R, C); const int Rb = Epi::PERM ? ((R & ~31) + perm32(R & 31)) : R;
        voffA[i] = (unsigned)(R * K + C) * 2u; voffB[i] = (unsigned)(Rb * K + C) * 2u; }
    const size_t kstep = (size_t)(BK * 2);
    const size_t hstep = (size_t)HALF * K * 2;
    const size_t tstep = 2 * hstep;
    const unsigned ldsw = (unsigned)wid * 1024u;
    const int aoff = lds_byte(wr * 64 + fr, fq * 8), boff = lds_byte(wc * 32 + fr, fq * 8);
#define PG8_SA(b, h) (((b) * 2 + (h)) * HTB)
#define PG8_SB(b, h) ((4 + (b) * 2 + (h)) * HTB)
#define PG8_STAGE(bufoff, gbase, voff) do { _Pragma("unroll") for (int _i = 0; _i < 2; ++_i) \
        __builtin_amdgcn_global_load_lds((const unsigned*)((const char*)(gbase) + (voff)[_i]), (PG8_LAS unsigned*)(lds + (bufoff) + ldsw + _i * 8192), 16, 0, 0); } while (0)
#define PG8_LDA(dst, b, h) do { _Pragma("unroll") for (int m = 0; m < 4; ++m) _Pragma("unroll") for (int k = 0; k < 2; ++k) dst[m][k] = *(const PG8_LAS bf16x8*)(lds + PG8_SA(b, h) + aoff + m * 2048 + k * 1024); } while (0)
#define PG8_LDB(dst, b, h) do { _Pragma("unroll") for (int n = 0; n < 2; ++n) _Pragma("unroll") for (int k = 0; k < 2; ++k) dst[n][k] = *(const PG8_LAS bf16x8*)(lds + PG8_SB(b, h) + boff + n * 2048 + k * 1024); } while (0)
#define PG8_MMA(ai, bj, At, Bt) do { __builtin_amdgcn_s_setprio(1); _Pragma("unroll") for (int m = 0; m < 4; ++m) _Pragma("unroll") for (int n = 0; n < 2; ++n) _Pragma("unroll") for (int k = 0; k < 2; ++k) \
        acc[ai][bj][m][n] = __builtin_amdgcn_mfma_f32_16x16x32_bf16(Bt[n][k], At[m][k], acc[ai][bj][m][n], 0, 0, 0); __builtin_amdgcn_s_setprio(0); } while (0)
#define PG8_WAIT_V(n) asm volatile("s_waitcnt vmcnt(" #n ")" ::: "memory")
#define PG8_WAIT_L(n) asm volatile("s_waitcnt lgkmcnt(" #n ")" ::: "memory")
#define PG8_BAR __builtin_amdgcn_s_barrier()
#define PG8_SCHED __builtin_amdgcn_sched_barrier(0)
    Unit cur, nxt; int ui = 0;
    if (!S.next(0, cur)) return;
    f32x4 acc[2][2][4][2];
#pragma unroll
    for (int a = 0; a < 2; ++a)
#pragma unroll
        for (int b = 0; b < 2; ++b)
#pragma unroll
            for (int m = 0; m < 4; ++m)
#pragma unroll
                for (int n = 0; n < 2; ++n) acc[a][b][m][n] = (f32x4){0.f, 0.f, 0.f, 0.f};
    bf16x8 At[4][2], B0[2][2], B1[2][2];
    const char* cA = (const char*)g.A + (size_t)cur.pm * tstep; const char* cB = (const char*)g.Bt + (size_t)cur.pn * tstep;
    S.a_ready(cur);
    PG8_STAGE(PG8_SB(0, 0), cB, voffB); PG8_STAGE(PG8_SA(0, 0), cA, voffA); PG8_STAGE(PG8_SB(0, 1), cB + hstep, voffB); PG8_STAGE(PG8_SA(0, 1), cA + hstep, voffA);
    if (wr == 1) PG8_BAR;
    PG8_WAIT_V(4); PG8_BAR;
    PG8_STAGE(PG8_SB(1, 0), cB + kstep, voffB); PG8_STAGE(PG8_SA(1, 0), cA + kstep, voffA); PG8_STAGE(PG8_SB(1, 1), cB + hstep + kstep, voffB);
    PG8_WAIT_V(6); PG8_BAR;
    PG8_STAMP();
    for (;;) {
        const bool has_next = S.next(ui + 1, nxt);
        const char* nA = has_next ? (const char*)g.A + (size_t)nxt.pm * tstep : cA; const char* nB = has_next ? (const char*)g.Bt + (size_t)nxt.pn * tstep : cB;
        for (int t = 0; t < nt; t += 2) {
            const bool last = (t == nt - 2);
            const char* a1 = cA + (size_t)(t + 1) * kstep;
            const char* a2 = last ? nA : cA + (size_t)(t + 2) * kstep; const char* b2 = last ? nB : cB + (size_t)(t + 2) * kstep;
            const char* a3 = a2 + kstep; const char* b3 = b2 + kstep;
            if (last && has_next) S.a_ready(nxt);
            PG8_LDB(B0, 0, 0); PG8_SCHED; PG8_LDA(At, 0, 0); PG8_STAGE(PG8_SA(1, 1), a1 + hstep, voffA);
            PG8_WAIT_L(8); PG8_BAR; PG8_WAIT_L(0); PG8_MMA(0, 0, At, B0); PG8_BAR; PG8_SCHED;
            PG8_LDB(B1, 0, 1); PG8_STAGE(PG8_SB(0, 0), b2, voffB);
            PG8_BAR; PG8_WAIT_L(0); PG8_MMA(0, 1, At, B1); PG8_BAR;
            PG8_LDA(At, 0, 1); PG8_STAGE(PG8_SA(0, 0), a2, voffA);
            PG8_BAR; PG8_WAIT_L(0); PG8_MMA(1, 0, At, B0); PG8_BAR; PG8_SCHED;
            PG8_STAGE(PG8_SB(0, 1), b2 + hstep, voffB);
            PG8_WAIT_V(6); PG8_BAR; PG8_MMA(1, 1, At, B1); PG8_BAR;
            PG8_LDB(B0, 1, 0); PG8_SCHED; PG8_LDA(At, 1, 0); PG8_STAGE(PG8_SA(0, 1), a2 + hstep, voffA);
            PG8_WAIT_L(8); PG8_BAR; PG8_WAIT_L(0); PG8_MMA(0, 0, At, B0); PG8_BAR; PG8_SCHED;
            PG8_LDB(B1, 1, 1); PG8_STAGE(PG8_SB(1, 0), b3, voffB);
            PG8_BAR; PG8_WAIT_L(0); PG8_MMA(0, 1, At, B1); PG8_BAR;
            PG8_LDA(At, 1, 1); PG8_STAGE(PG8_SA(1, 0), a3, voffA);
            PG8_BAR; PG8_WAIT_L(0); PG8_MMA(1, 0, At, B0); PG8_BAR; PG8_SCHED;
            PG8_STAGE(PG8_SB(1, 1), b3 + hstep, voffB);
            PG8_WAIT_V(6); PG8_BAR; PG8_MMA(1, 1, At, B1); PG8_BAR;
        }
        PG8_STAMP();
        if constexpr (!Epi::AFTER_DRAIN) { E(acc, cur, wr, wc, fr, fq); S.done(cur); }
        PG8_STAMP();
        if (!has_next) break;
#pragma unroll
        for (int a = 0; a < 2; ++a)
#pragma unroll
            for (int b = 0; b < 2; ++b)
#pragma unroll
                for (int m = 0; m < 4; ++m)
#pragma unroll
                    for (int n = 0; n < 2; ++n) acc[a][b][m][n] = (f32x4){0.f, 0.f, 0.f, 0.f};
        cur = nxt; cA = nA; cB = nB; ++ui;
    }
    PG8_WAIT_V(0);
    if (wr == 0) PG8_BAR;
    PG8_BAR;
    if constexpr (Epi::AFTER_DRAIN) { E.fused(acc, cur, wr, wc, fr, fq, lds, wid, lane); S.done(cur); }
    PG8_STAMP();
    if (STAMP && wid == 0) { stamps[lane] = lane < nts ? (((unsigned long long)(unsigned)ts_hi << 32) | (unsigned)ts_lo) : 0ull;
        if (lane == 62) stamps[62] = rt_entry; if (lane == 63) stamps[63] = (unsigned long long)wall_clock64(); }
#undef PG8_STAMP
#undef PG8_SA
#undef PG8_SB
#undef PG8_STAGE
#undef PG8_LDA
#undef PG8_LDB
#undef PG8_MMA
#undef PG8_WAIT_V
#undef PG8_WAIT_L
#undef PG8_BAR
#undef PG8_SCHED
}
}

#define LAS __attribute__((address_space(3)))
#define XB_TMO      128
#define XB_XCNT(j)  (256  + 64 * (j))
#define XB_XSUB(j)  (1280 + 64 * (j))
#define XB_XGEN(j)  (2304 + 64 * (j))
#define XB_TOP      3328
#define XB_TOPGEN   3392
#define XCD_BAR_WORDS 3456
#define XB_SPIN_CAP (1u << 18)

__device__ __forceinline__ unsigned xb_ld(unsigned* p)              { return __hip_atomic_load(p, __ATOMIC_RELAXED, __HIP_MEMORY_SCOPE_AGENT); }
__device__ __forceinline__ unsigned xb_add(unsigned* p, unsigned v) { return __hip_atomic_fetch_add(p, v, __ATOMIC_RELAXED, __HIP_MEMORY_SCOPE_AGENT); }
__device__ __forceinline__ unsigned xb_xcc_id() { return (unsigned)__builtin_amdgcn_s_getreg((3 << 11) | 20) & 0xFu; }
#define XB_SPIN(cond, bar) do { unsigned _sp = 0; while (cond) { __builtin_amdgcn_s_sleep(1); \
    if ((++_sp & 255u) == 0u) { if (xb_ld(&(bar)[XB_TMO])) break; if (_sp > XB_SPIN_CAP) { atomicAdd(&(bar)[XB_TMO], 1u); break; } } } } while (0)

struct XcdBarrier {
    unsigned* bar; unsigned x;
    volatile LAS unsigned* st;
};

__device__ __forceinline__ XcdBarrier xcd_barrier_post(unsigned* bar, volatile LAS unsigned* st) {
    XcdBarrier b; b.bar = bar; b.x = xb_xcc_id(); b.st = st;
    if (threadIdx.x == 0) (void)xb_add(&bar[XB_XCNT(b.x)], 1u);
    return b;
}
__device__ __forceinline__ void xcd_barrier_complete(unsigned* bar, unsigned x, unsigned& nloc, unsigned& nx) {
    const unsigned G = gridDim.x * gridDim.y * gridDim.z;
    unsigned sum, cnt, mine, sp = 0u;
    for (;;) {
        sum = 0u; cnt = 0u; mine = 0u;
#pragma unroll
        for (unsigned j = 0; j < 16; ++j) { const unsigned c = xb_ld(&bar[XB_XCNT(j)]); sum += c; cnt += (c > 0u) ? 1u : 0u; mine = (j == x) ? c : mine; }
        if (sum == G) break;
        __builtin_amdgcn_s_sleep(1);
        if ((++sp & 255u) == 0u) { if (xb_ld(&bar[XB_TMO])) break; if (sp > XB_SPIN_CAP) { atomicAdd(&bar[XB_TMO], 1u); break; } }
    }
    nloc = mine > 0u ? mine : 1u; nx = cnt > 0u ? cnt : 1u;
}

__device__ __forceinline__ void xcd_barrier(const XcdBarrier& b) {
    asm volatile("s_waitcnt vmcnt(0)" ::: "memory");
    __syncthreads();
    if (threadIdx.x == 0) {
        unsigned* bar = b.bar;
        __builtin_amdgcn_s_waitcnt(0);
        unsigned nloc = b.st[0], nx = b.st[1];
        if (nloc == 0u) { xcd_barrier_complete(bar, b.x, nloc, nx); b.st[0] = nloc; b.st[1] = nx; }
        const unsigned old = xb_add(&bar[XB_XSUB(b.x)], 1u);
        const unsigned gen = old / nloc;
        if (old + 1u == (gen + 1u) * nloc) {
            __builtin_amdgcn_fence(__ATOMIC_RELEASE, "agent");
            asm volatile("s_waitcnt vmcnt(0)" ::: "memory");
            const unsigned og = xb_add(&bar[XB_TOP], 1u);
            const unsigned tg = og / nx;
            if (og + 1u == (tg + 1u) * nx) xb_add(&bar[XB_TOPGEN], 1u);
            else XB_SPIN(xb_ld(&bar[XB_TOPGEN]) == tg, bar);
            __builtin_amdgcn_fence(__ATOMIC_ACQUIRE, "agent");
            xb_add(&bar[XB_XGEN(b.x)], 1u);
            asm volatile("s_waitcnt vmcnt(0)" ::: "memory");
        } else {
            XB_SPIN(xb_ld(&bar[XB_XGEN(b.x)]) == gen, bar);
            __builtin_amdgcn_fence(__ATOMIC_ACQUIRE, "agent");
            asm volatile("s_waitcnt vmcnt(0)" ::: "memory");
        }
    }
    __syncthreads();
}


typedef unsigned short bf16_t;
typedef short bf16x8 __attribute__((ext_vector_type(8)));
typedef short bf16x4 __attribute__((ext_vector_type(4)));
typedef float f32x4 __attribute__((ext_vector_type(4)));
typedef unsigned u32x4 __attribute__((ext_vector_type(4)));
typedef unsigned u32x2 __attribute__((ext_vector_type(2)));

constexpr int T_TOK = 16384, DMODEL = 4096, SEQ = 8192, NPROJ = 16384, NIN = 16416, NPAD = 16640;
constexpr int LDS_BYTES = 131072 + 16;
constexpr size_t OFF_XN = 0, OFF_WINT = 134217728ull, OFF_WOUTT = 270532608ull, OFF_PROJ = 304087040ull, OFF_GATE = 840957952ull,
                 OFF_MIXED = 843055104ull, OFF_AB = 977272832ull, OFF_LSE = 1010827264ull, OFF_CD = 1013972992ull, WS_END = 1013989376ull, WS_BAR = WS_END + (8ull << 20);
constexpr size_t OFF_WB = 0, OFF_UB = 67108864ull, OFF_QD = 134217728ull, OFF_KT = 201326592ull;
constexpr size_t OUT_OP = 0, OUT_ODN = 201326592ull;

struct Params {
    const float* x; const float* norm_g; const float* w_in; const float* conv_w; const float* a_log; const float* dt_bias; const float* dn_norm_g; const float* w_out; const float* final_g;
    float* out; unsigned char* ws; int mask; int coop;
};

typedef __bf16 bf16v2_t __attribute__((ext_vector_type(2)));
typedef float f32v2_t __attribute__((ext_vector_type(2)));
__device__ __forceinline__ unsigned cvt_pk(float lo, float hi) { f32v2_t v = {lo, hi}; bf16v2_t b = __builtin_convertvector(v, bf16v2_t); return __builtin_bit_cast(unsigned, b); }
__device__ __forceinline__ float bflo(unsigned w) { return __uint_as_float(w << 16); }
__device__ __forceinline__ float bfhi(unsigned w) { return __uint_as_float(w & 0xffff0000u); }
__device__ __forceinline__ float bf2f(bf16_t v) { return __uint_as_float(((unsigned)v) << 16); }
__device__ __forceinline__ bf16_t f2bf(float f) { return (bf16_t)(cvt_pk(f, 0.f) & 0xffffu); }
__device__ __forceinline__ float silu_f(float v) { return v / (1.0f + __expf(-v)); }
__device__ __forceinline__ f32x4 mfma32(bf16x8 a, bf16x8 b, f32x4 c) { return __builtin_amdgcn_mfma_f32_16x16x32_bf16(a, b, c, 0, 0, 0); }
__device__ __forceinline__ f32x4 mfma16(bf16x4 a, bf16x4 b, f32x4 c) { return __builtin_amdgcn_mfma_f32_16x16x16bf16_1k(a, b, c, 0, 0, 0); }

struct EpiProj {
    static constexpr bool PERM = true, AFTER_DRAIN = false;
    bf16_t* O; float* gate;
    __device__ __forceinline__ void operator()(const f32x4 (&acc)[2][2][4][2], const pg8::Unit& u, int wr, int wc, int fr, int fq) const {
        const int row0 = u.pm * 256 + wr * 64 + fr;
        if (u.pn < 64) {
            const int col0 = u.pn * 256 + wc * 32 + 8 * fq;
#pragma unroll
            for (int ai = 0; ai < 2; ++ai)
#pragma unroll
                for (int m = 0; m < 4; ++m) { bf16_t* rowp = O + (size_t)(row0 + ai * 128 + m * 16) * NPROJ + col0;
#pragma unroll
                    for (int bj = 0; bj < 2; ++bj) { const f32x4 v0 = acc[ai][bj][m][0], v1 = acc[ai][bj][m][1];
                        u32x4 w; w.x = cvt_pk(v0[0], v0[1]); w.y = cvt_pk(v0[2], v0[3]); w.z = cvt_pk(v1[0], v1[1]); w.w = cvt_pk(v1[2], v1[3]);
                        *(u32x4*)(rowp + bj * 128) = w; } }
        } else if (wc == 0) {
#pragma unroll
            for (int ai = 0; ai < 2; ++ai)
#pragma unroll
                for (int m = 0; m < 4; ++m) { float* gp = gate + (size_t)(row0 + ai * 128 + m * 16) * 32 + 8 * fq;
                    *(f32x4*)gp = acc[ai][0][m][0]; *(f32x4*)(gp + 4) = acc[ai][0][m][1]; }
        }
    }
};
struct EpiResid {
    static constexpr bool PERM = false, AFTER_DRAIN = false;
    float* C; const float* X;
    __device__ __forceinline__ void operator()(const f32x4 (&acc)[2][2][4][2], const pg8::Unit& u, int wr, int wc, int fr, int fq) const {
        const int row0 = u.pm * 256 + wr * 64 + fr, col0 = u.pn * 256 + wc * 32 + 4 * fq;
#pragma unroll
        for (int ai = 0; ai < 2; ++ai)
#pragma unroll
            for (int m = 0; m < 4; ++m) { const size_t off = (size_t)(row0 + ai * 128 + m * 16) * DMODEL + col0;
#pragma unroll
                for (int bj = 0; bj < 2; ++bj)
#pragma unroll
                    for (int n = 0; n < 2; ++n) { const f32x4 xv = *(const f32x4*)(X + off + bj * 128 + n * 16); *(f32x4*)(C + off + bj * 128 + n * 16) = acc[ai][bj][m][n] + xv; } }
    }
};

struct EpiResidBf {
    static constexpr bool PERM = true, AFTER_DRAIN = false;
    bf16_t* H; const float* X;
    __device__ __forceinline__ void operator()(const f32x4 (&acc)[2][2][4][2], const pg8::Unit& u, int wr, int wc, int fr, int fq) const {
        const int row0 = u.pm * 256 + wr * 64 + fr, col0 = u.pn * 256 + wc * 32 + 8 * fq;
#pragma unroll
        for (int ai = 0; ai < 2; ++ai)
#pragma unroll
            for (int m = 0; m < 4; ++m) { const size_t off = (size_t)(row0 + ai * 128 + m * 16) * DMODEL + col0;
#pragma unroll
                for (int bj = 0; bj < 2; ++bj) { const f32x4 x0 = __builtin_nontemporal_load((const f32x4*)(X + off + bj * 128)), x1 = __builtin_nontemporal_load((const f32x4*)(X + off + bj * 128 + 4));
                    const f32x4 v0 = acc[ai][bj][m][0] + x0, v1 = acc[ai][bj][m][1] + x1;
                    u32x4 w; w.x = cvt_pk(v0[0], v0[1]); w.y = cvt_pk(v0[2], v0[3]); w.z = cvt_pk(v1[0], v1[1]); w.w = cvt_pk(v1[2], v1[3]);
                    *(u32x4*)(H + off + bj * 128) = w; } }
    }
};
struct RepOrder : pg8::StaticOrder {
    int reps;
    __device__ bool next(int i, pg8::Unit& u) const {
        const long L = (long)i * G + c; if (L >= (long)nwg * reps) return false;
        int wgid = (int)(L % nwg); { const int q = nwg / pg8::NXCD, r = nwg % pg8::NXCD, xcd = wgid % pg8::NXCD, off = wgid / pg8::NXCD; wgid = (xcd < r ? xcd * (q + 1) : r * (q + 1) + (xcd - r) * q) + off; }
        const int nig = pg8::WGM * nN, gid = wgid / nig, fm = gid * pg8::WGM, gsz = (nM - fm) < pg8::WGM ? (nM - fm) : pg8::WGM;
        u.pm = fm + ((wgid % nig) % gsz); u.pn = nN - 1 - (wgid % nig) / gsz; return true;
    }
};
__device__ __forceinline__ float wave_sum(float v) {
#pragma unroll
    for (int o = 32; o >= 1; o >>= 1) v += __shfl_xor(v, o);
    return v;
}
__device__ void phase_rmsnorm_x(const float* __restrict__ x, const float* __restrict__ g, bf16_t* __restrict__ xn) {
    const int wid = threadIdx.x >> 6, lane = threadIdx.x & 63;
    const int gw = blockIdx.x * 8 + wid, nw = gridDim.x * 8;
    for (int row = gw; row < T_TOK; row += nw) {
        const f32x4* xr = (const f32x4*)(x + (size_t)row * DMODEL);
        f32x4 v[16]; float ss = 0.f;
#pragma unroll
        for (int i = 0; i < 16; ++i) { v[i] = __builtin_nontemporal_load(xr + i * 64 + lane); ss += v[i][0] * v[i][0] + v[i][1] * v[i][1] + v[i][2] * v[i][2] + v[i][3] * v[i][3]; }
        ss = wave_sum(ss);
        const float rstd = rsqrtf(ss * (1.0f / DMODEL) + 1e-6f);
        bf16_t* orow = xn + (size_t)row * DMODEL;
#pragma unroll
        for (int i = 0; i < 16; ++i) { const f32x4 gg = ((const f32x4*)g)[i * 64 + lane]; u32x2 w; w.x = cvt_pk(v[i][0] * rstd * gg[0], v[i][1] * rstd * gg[1]); w.y = cvt_pk(v[i][2] * rstd * gg[2], v[i][3] * rstd * gg[3]);
            *(u32x2*)(orow + (i * 64 + lane) * 4) = w; }
    }
}
__device__ void phase_transpose(LAS unsigned char* lds, const float* __restrict__ W, int K, int N, int Npad, bf16_t* __restrict__ Wt) {
    const int wid = threadIdx.x >> 6, lane = threadIdx.x & 63;
    const int gw = blockIdx.x * 8 + wid, nw = gridDim.x * 8;
    const int nkt = K / 64, total = nkt * (Npad / 32);
    LAS bf16_t* tl = (LAS bf16_t*)(lds + wid * 4352);
    const int c4 = lane & 7, kr = lane >> 3, rn = lane >> 1, half = lane & 1;
    for (int tile = gw; tile < total; tile += nw) {
        const int nnt = Npad / 32, kt = tile / nnt, nt = tile - kt * nnt, n0 = nt * 32, k0 = kt * 64;
        const int n = n0 + 4 * c4;
#pragma unroll
        for (int it = 0; it < 8; ++it) { const int k = it * 8 + kr;
            f32x4 v = (f32x4){0.f, 0.f, 0.f, 0.f};
            if (n < N) v = __builtin_nontemporal_load((const f32x4*)(W + (size_t)(k0 + k) * N + n));
            const unsigned p0 = cvt_pk(v[0], v[1]), p1 = cvt_pk(v[2], v[3]);
            tl[(4 * c4 + 0) * 66 + k] = (bf16_t)(p0 & 0xffffu); tl[(4 * c4 + 1) * 66 + k] = (bf16_t)(p0 >> 16);
            tl[(4 * c4 + 2) * 66 + k] = (bf16_t)(p1 & 0xffffu); tl[(4 * c4 + 3) * 66 + k] = (bf16_t)(p1 >> 16); }
        asm volatile("s_waitcnt lgkmcnt(0)" ::: "memory");
        __builtin_amdgcn_wave_barrier();
        const LAS unsigned* rp = (const LAS unsigned*)(tl + rn * 66 + 32 * half);
        unsigned d[16];
#pragma unroll
        for (int i = 0; i < 16; ++i) d[i] = rp[i];
        bf16_t* op = Wt + (size_t)(n0 + rn) * K + k0 + 32 * half;
#pragma unroll
        for (int i = 0; i < 4; ++i) *(u32x4*)(op + 8 * i) = (u32x4){d[4 * i], d[4 * i + 1], d[4 * i + 2], d[4 * i + 3]};
        asm volatile("s_waitcnt lgkmcnt(0)" ::: "memory");
        __builtin_amdgcn_wave_barrier();
    }
}

__device__ __forceinline__ void gate_gemm(LAS unsigned char* lds, const bf16_t* __restrict__ xn, const bf16_t* __restrict__ WinT, float* __restrict__ gate, int rb) {
    const int tid = threadIdx.x, wid = tid >> 6, lane = tid & 63, fr = lane & 15, g = lane >> 4;
    f32x4 acc[4][2];
#pragma unroll
    for (int mt = 0; mt < 4; ++mt) { acc[mt][0] = (f32x4){0.f, 0.f, 0.f, 0.f}; acc[mt][1] = (f32x4){0.f, 0.f, 0.f, 0.f}; }
    const bf16_t* arow = xn + (size_t)(rb * 64 + fr) * DMODEL + wid * 512 + 8 * g;
    const bf16_t* brow = WinT + (size_t)(NPROJ + fr) * DMODEL + wid * 512 + 8 * g;
#pragma unroll 4
    for (int ks = 0; ks < 16; ++ks) {
        bf16x8 a[4], b[2];
#pragma unroll
        for (int mt = 0; mt < 4; ++mt) a[mt] = *(const bf16x8*)(arow + (size_t)(16 * mt) * DMODEL + 32 * ks);
#pragma unroll
        for (int nt = 0; nt < 2; ++nt) b[nt] = *(const bf16x8*)(brow + (size_t)(16 * nt) * DMODEL + 32 * ks);
#pragma unroll
        for (int mt = 0; mt < 4; ++mt)
#pragma unroll
            for (int nt = 0; nt < 2; ++nt) acc[mt][nt] = mfma32(a[mt], b[nt], acc[mt][nt]);
    }
    LAS float* red = (LAS float*)lds;
#pragma unroll
    for (int mt = 0; mt < 4; ++mt)
#pragma unroll
        for (int nt = 0; nt < 2; ++nt)
#pragma unroll
            for (int reg = 0; reg < 4; ++reg) red[(wid * 64 + 16 * mt + 4 * g + reg) * 32 + 16 * nt + fr] = acc[mt][nt][reg];
    __syncthreads();
#pragma unroll
    for (int i = 0; i < 4; ++i) { const int e = tid + 512 * i; float s = 0.f;
#pragma unroll
        for (int w = 0; w < 8; ++w) s += red[w * 2048 + e];
        gate[(size_t)(rb * 64) * 32 + e] = s; }
    __syncthreads();
}

constexpr int N_ATTN_TASKS = 3 * 2 * 16 * 64;
#define LDS_BARRIER() do { asm volatile("s_waitcnt lgkmcnt(0)" ::: "memory"); __builtin_amdgcn_s_barrier(); asm volatile("" ::: "memory"); } while (0)
struct AttnPre { u32x4 k[8], v[8]; bf16x8 q[4]; };
struct AttnTask { int p, b, h, n, dil, tb; };
__device__ __forceinline__ AttnTask attn_decode(int task) {
    AttnTask t; t.p = task >> 11; const int rem = task & 2047; t.b = rem >> 10; t.h = (rem >> 6) & 15; const int idx = rem & 63;
    const int dsh = 2 * t.p, nbp = 64 >> dsh; t.dil = 1 << dsh; const int r = idx >> (6 - dsh); t.n = idx & (nbp - 1); t.tb = t.b * SEQ + r; return t;
}
__device__ __forceinline__ void attn_prefetch(AttnPre& P, const bf16_t* __restrict__ proj, int task, bool cont, int tid) {
    const AttnTask t = attn_decode(task);
    const int jb = cont ? 128 : 0;
#pragma unroll
    for (int i = 0; i < 4; ++i) {
        const int c = tid + 512 * i, j = jb + (c >> 4), ch = c & 15, idxk = (t.n - 1) * 128 + j;
        const bf16_t* rowp = proj + (size_t)(t.tb + (idxk < 0 ? 0 : idxk) * t.dil) * NPROJ + t.h * 128 + ch * 8;
        P.k[i] = *(const u32x4*)(rowp + 2048); P.v[i] = *(const u32x4*)(rowp + 4096);
    }
    if (!cont) {
#pragma unroll
        for (int i = 4; i < 8; ++i) {
            const int c = tid + 512 * i, j = c >> 4, ch = c & 15, idxk = (t.n - 1) * 128 + j;
            const bf16_t* rowp = proj + (size_t)(t.tb + (idxk < 0 ? 0 : idxk) * t.dil) * NPROJ + t.h * 128 + ch * 8;
            P.k[i] = *(const u32x4*)(rowp + 2048); P.v[i] = *(const u32x4*)(rowp + 4096);
        }
    }
    { const int wid = tid >> 6, lane = tid & 63, fr = lane & 15, g = lane >> 4;
      const bf16_t* qrow = proj + (size_t)(t.tb + (t.n * 128 + 16 * wid + fr) * t.dil) * NPROJ + t.h * 128;
#pragma unroll
      for (int s = 0; s < 4; ++s) P.q[s] = *(const bf16x8*)(qrow + 32 * s + 8 * g); }
}
__device__ __forceinline__ void attn_compute(LAS unsigned char* lds, const bf16_t* __restrict__ proj, bf16_t* __restrict__ op, float* __restrict__ lsep, int task, int next_task, bool cont, bool next_cont, int par, AttnPre& P) {
    const int tid = threadIdx.x, wid = tid >> 6, lane = tid & 63, fr = lane & 15, g = lane >> 4;
    const AttnTask t = attn_decode(task);
    const int p = t.p, h = t.h, n = t.n, dil = t.dil, px = par << 7;
    const float slope = exp2f(-0.5f * (float)(h + 1));
    { const int jb = cont ? 128 : 0;
#pragma unroll
      for (int i = 0; i < 4; ++i) {
          const int c = tid + 512 * i, j = jb + (c >> 4), ch = c & 15, idxk = (n - 1) * 128 + j, jp = j ^ px;
          u32x4 kv = P.k[i], vv = P.v[i];
          if (idxk < 0) { kv = (u32x4){0u, 0u, 0u, 0u}; vv = (u32x4){0u, 0u, 0u, 0u}; }
          *(LAS u32x4*)(lds + jp * 256 + ((ch ^ (j & 15)) << 4)) = kv;
          *(LAS u32x4*)(lds + 65536 + jp * 256 + ((ch ^ ((j & 7) << 1)) << 4)) = vv;
      }
      if (!cont) {
#pragma unroll
          for (int i = 4; i < 8; ++i) {
              const int c = tid + 512 * i, j = c >> 4, ch = c & 15, idxk = (n - 1) * 128 + j, jp = j ^ px;
              u32x4 kv = P.k[i], vv = P.v[i];
              if (idxk < 0) { kv = (u32x4){0u, 0u, 0u, 0u}; vv = (u32x4){0u, 0u, 0u, 0u}; }
              *(LAS u32x4*)(lds + jp * 256 + ((ch ^ (j & 15)) << 4)) = kv;
              *(LAS u32x4*)(lds + 65536 + jp * 256 + ((ch ^ ((j & 7) << 1)) << 4)) = vv;
          }
      } }
    const int tq = t.tb + (n * 128 + 16 * wid + fr) * dil;
    bf16x8 qf[4];
#pragma unroll
    for (int s = 0; s < 4; ++s) qf[s] = P.q[s];
    LDS_BARRIER();
    if (next_task >= 0) attn_prefetch(P, proj, next_task, next_cont, tid);
    float sc[9][4];
    float mx = -1e30f;
#pragma unroll
    for (int kt9 = 0; kt9 < 9; ++kt9) {
        const int kt = wid + kt9, jr = (16 * kt) ^ px;
        f32x4 acc = (f32x4){0.f, 0.f, 0.f, 0.f};
#pragma unroll
        for (int s = 0; s < 4; ++s) { const bf16x8 kf = *(const LAS bf16x8*)(lds + (jr + fr) * 256 + (((4 * s + g) ^ fr) << 4)); acc = mfma32(kf, qf[s], acc); }
#pragma unroll
        for (int reg = 0; reg < 4; ++reg) { const int j = 16 * kt + 4 * g + reg, l = 16 * wid + fr, dist = l + 128 - j;
            const bool valid = (dist >= 0) && (dist <= 128) && (n > 0 || j >= 128);
            const float v = valid ? acc[reg] * 0.08838834764831845f - slope * (float)(dist * dil) : -1e30f;
            sc[kt9][reg] = v; mx = fmaxf(mx, v); }
    }
    mx = fmaxf(mx, __shfl_xor(mx, 16)); mx = fmaxf(mx, __shfl_xor(mx, 32));
    float sum = 0.f;
    bf16x4 pk[9];
#pragma unroll
    for (int kt9 = 0; kt9 < 9; ++kt9) {
        float e[4];
#pragma unroll
        for (int reg = 0; reg < 4; ++reg) { e[reg] = __expf(sc[kt9][reg] - mx); sum += e[reg]; }
        u32x2 w; w.x = cvt_pk(e[0], e[1]); w.y = cvt_pk(e[2], e[3]);
        pk[kt9] = __builtin_bit_cast(bf16x4, w);
    }
    sum += __shfl_xor(sum, 16); sum += __shfl_xor(sum, 32);
    const float inv = 1.0f / sum, lse = mx + __logf(sum);
    bf16_t* orow = op + ((size_t)p * T_TOK + tq) * 2048 + h * 128;
    const int tq4 = fr >> 2, tp4 = fr & 3, krow = 4 * g + tq4;
    const unsigned vbase = (unsigned)(size_t)lds + 65536u + (unsigned)(krow * 256 + 8 * (tp4 & 1));
    unsigned rt[9];
#pragma unroll
    for (int kt9 = 0; kt9 < 9; ++kt9) rt[kt9] = (unsigned)(((16 * (wid + kt9)) ^ px) * 256);
#pragma unroll
    for (int dt = 0; dt < 8; ++dt) {
        f32x4 acc = (f32x4){0.f, 0.f, 0.f, 0.f};
        const unsigned va = vbase + (unsigned)((((2 * dt + (tp4 >> 1)) ^ ((krow & 7) << 1))) << 4);
        unsigned ad[9];
#pragma unroll
        for (int kt9 = 0; kt9 < 9; ++kt9) ad[kt9] = va + rt[kt9];
        u32x2 vt[9];
        asm volatile("ds_read_b64_tr_b16 %0, %9\n\tds_read_b64_tr_b16 %1, %10\n\tds_read_b64_tr_b16 %2, %11\n\tds_read_b64_tr_b16 %3, %12\n\t"
                     "ds_read_b64_tr_b16 %4, %13\n\tds_read_b64_tr_b16 %5, %14\n\tds_read_b64_tr_b16 %6, %15\n\tds_read_b64_tr_b16 %7, %16\n\t"
                     "ds_read_b64_tr_b16 %8, %17\n\ts_waitcnt lgkmcnt(0)"
                     : "=&v"(vt[0]), "=&v"(vt[1]), "=&v"(vt[2]), "=&v"(vt[3]), "=&v"(vt[4]), "=&v"(vt[5]), "=&v"(vt[6]), "=&v"(vt[7]), "=&v"(vt[8])
                     : "v"(ad[0]), "v"(ad[1]), "v"(ad[2]), "v"(ad[3]), "v"(ad[4]), "v"(ad[5]), "v"(ad[6]), "v"(ad[7]), "v"(ad[8]) : "memory");
#pragma unroll
        for (int kt9 = 0; kt9 < 9; ++kt9) acc = mfma16(__builtin_bit_cast(bf16x4, vt[kt9]), pk[kt9], acc);
        u32x2 w; w.x = cvt_pk(acc[0] * inv, acc[1] * inv); w.y = cvt_pk(acc[2] * inv, acc[3] * inv);
        *(u32x2*)(orow + 16 * dt + 4 * g) = w;
    }
    if (g == 0) lsep[((size_t)p * T_TOK + tq) * 16 + h] = lse;
    LDS_BARRIER();
}
__device__ __forceinline__ void attn_phase(LAS unsigned char* lds, const bf16_t* __restrict__ proj, bf16_t* __restrict__ op, float* __restrict__ lsep, int t0, int t1) {
    const int tid = threadIdx.x;
    if (t0 >= t1) return;
    AttnPre P;
    attn_prefetch(P, proj, t0, false, tid);
    int par = 0; bool cont = false;
    for (int task = t0; task < t1; ++task) {
        const int nxt = task + 1 < t1 ? task + 1 : -1;
        const bool next_cont = nxt >= 0 && attn_decode(nxt).n > 0;
        attn_compute(lds, proj, op, lsep, task, nxt, cont, next_cont, par, P);
        cont = next_cont; par = next_cont ? (par ^ 1) : 0;
    }
    __syncthreads();
}

constexpr int DN_Q = 0, DN_K = 17408, DN_V = 34816, DN_AD = 52224, DN_ABF = 56320, DN_TBF = 65536, DN_GC = 68608, DN_BETA = 68864, DN_EG = 69120, DN_CW = 69376;
__device__ void dn_stage_convw(LAS unsigned char* lds, const float* __restrict__ conv_w, int h) {
    LAS float* cw_s = (LAS float*)(lds + DN_CW);
    for (int e = threadIdx.x; e < 1536; e += 512) { const int j = e / 384, r = e - j * 384, X = r >> 7, col = r & 127; cw_s[e] = conv_w[j * 6144 + X * 2048 + h * 128 + col]; }
    __syncthreads();
}
template <int X> __device__ __forceinline__ void dn_conv_block(LAS unsigned char* lds, const LAS float* cw_s, const u32x4 (&xin)[2][4], int s0, int i, int cg8) {
    float y[16];
#pragma unroll
    for (int hf = 0; hf < 2; ++hf) {
        float acc[8];
#pragma unroll
        for (int e = 0; e < 8; ++e) acc[e] = 0.f;
#pragma unroll
        for (int j = 0; j < 4; ++j) { const int sp = s0 + i - 3 + j; const float mj = sp >= 0 ? 1.0f : 0.0f;
            const u32x4 xv = xin[hf][j];
            const f32x4 w0 = *(const LAS f32x4*)(cw_s + j * 384 + X * 128 + 16 * cg8 + 8 * hf) * mj, w1 = *(const LAS f32x4*)(cw_s + j * 384 + X * 128 + 16 * cg8 + 8 * hf + 4) * mj;
            acc[0] += w0[0] * bflo(xv.x); acc[1] += w0[1] * bfhi(xv.x); acc[2] += w0[2] * bflo(xv.y); acc[3] += w0[3] * bfhi(xv.y);
            acc[4] += w1[0] * bflo(xv.z); acc[5] += w1[1] * bfhi(xv.z); acc[6] += w1[2] * bflo(xv.w); acc[7] += w1[3] * bfhi(xv.w); }
#pragma unroll
        for (int e = 0; e < 8; ++e) y[hf * 8 + e] = silu_f(acc[e]);
        asm volatile("" ::: "memory");
    }
    if (X < 2) { float ss = 0.f;
#pragma unroll
        for (int e = 0; e < 16; ++e) ss += y[e] * y[e];
        ss += __shfl_xor(ss, 1); ss += __shfl_xor(ss, 2); ss += __shfl_xor(ss, 4);
        const float scl = rsqrtf(ss + 1e-6f) * (X == 0 ? 0.08838834764831845f : 1.0f);
#pragma unroll
        for (int e = 0; e < 16; ++e) y[e] *= scl; }
    LAS u32x4* dst = (LAS u32x4*)(lds + X * 17408 + i * 272 + cg8 * 32);
    dst[0] = (u32x4){cvt_pk(y[0], y[1]), cvt_pk(y[2], y[3]), cvt_pk(y[4], y[5]), cvt_pk(y[6], y[7])};
    dst[1] = (u32x4){cvt_pk(y[8], y[9]), cvt_pk(y[10], y[11]), cvt_pk(y[12], y[13]), cvt_pk(y[14], y[15])};
}
struct PrepPre { u32x4 x[2][2][4]; float bl, al, alog, dtb; };
__device__ __forceinline__ void dn_prep_prefetch(PrepPre& P, const bf16_t* __restrict__ proj, const float* __restrict__ gate, const float* __restrict__ a_log, const float* __restrict__ dt_bias, int chunk) {
    const int tid = threadIdx.x, wid = tid >> 6, lane = tid & 63;
    const int bh = chunk >> 7, n = chunk & 127, b = bh >> 4, h = bh & 15, s0 = n * 64, i = tid >> 3, cg8 = tid & 7;
#pragma unroll
    for (int X = 0; X < 2; ++X)
#pragma unroll
        for (int hf = 0; hf < 2; ++hf)
#pragma unroll
            for (int j = 0; j < 4; ++j) { const int sp = s0 + i - 3 + j;
                P.x[X][hf][j] = *(const u32x4*)(proj + ((size_t)b * SEQ + (sp < 0 ? 0 : sp)) * NPROJ + 8192 + X * 2048 + h * 128 + 16 * cg8 + 8 * hf); }
    if (wid == 0) { const size_t t0 = (size_t)b * SEQ + s0; P.bl = gate[(t0 + lane) * 32 + h]; P.al = gate[(t0 + lane) * 32 + 16 + h]; P.alog = a_log[h]; P.dtb = dt_bias[h]; }
}
__device__ __forceinline__ void dn_prep_chunk(LAS unsigned char* lds, const bf16_t* __restrict__ proj, const float* __restrict__ gate, const float* __restrict__ a_log, const float* __restrict__ dt_bias,
                              bf16_t* __restrict__ Wb, bf16_t* __restrict__ Uf, bf16_t* __restrict__ Qd, bf16_t* __restrict__ Kt, bf16_t* __restrict__ Ab, float* __restrict__ Cd, int chunk, int next_chunk, PrepPre& P) {
    int tid_ = threadIdx.x; asm volatile("" : "+v"(tid_));
    const int tid = tid_, wid = tid >> 6, lane = tid & 63, fr = lane & 15, g = lane >> 4;
    const int bh = chunk >> 7, n = chunk & 127, b = bh >> 4, h = bh & 15;
    const int s0 = n * 64;
    LAS float* cw_s = (LAS float*)(lds + DN_CW);
    LAS float* Ad = (LAS float*)(lds + DN_AD); LAS float* gc_s = (LAS float*)(lds + DN_GC); LAS float* beta_s = (LAS float*)(lds + DN_BETA); LAS float* eg_s = (LAS float*)(lds + DN_EG);
    {
        const int i = tid >> 3, cg8 = tid & 7;
        u32x4 xv2[2][4];
#pragma unroll
        for (int hf = 0; hf < 2; ++hf)
#pragma unroll
            for (int j = 0; j < 4; ++j) { const int sp = s0 + i - 3 + j;
                xv2[hf][j] = *(const u32x4*)(proj + ((size_t)b * SEQ + (sp < 0 ? 0 : sp)) * NPROJ + 8192 + 2 * 2048 + h * 128 + 16 * cg8 + 8 * hf); }
        dn_conv_block<0>(lds, cw_s, P.x[0], s0, i, cg8);
        dn_conv_block<1>(lds, cw_s, P.x[1], s0, i, cg8);
        dn_conv_block<2>(lds, cw_s, xv2, s0, i, cg8);
    }
    if (wid == 0) {
        const float beta = 1.0f / (1.0f + expf(-P.bl));
        const float xx = P.al + P.dtb;
        const float sp = xx > 20.f ? xx : log1pf(expf(xx));
        float gc = -expf(P.alog) * sp;
#pragma unroll
        for (int off = 1; off < 64; off <<= 1) { const float v = __shfl_up(gc, off); if (lane >= off) gc += v; }
        gc_s[lane] = gc; beta_s[lane] = beta; eg_s[lane] = expf(gc);
    }
    LDS_BARRIER();
    if (next_chunk >= 0) dn_prep_prefetch(P, proj, gate, a_log, dt_bias, next_chunk);
    {
        const int type = wid >> 2, ti = wid & 3;
        const int i = 16 * ti + fr; const float gi = gc_s[i], bi = beta_s[i];
#pragma unroll
        for (int tj = 0; tj < 4; ++tj) {
            const size_t aoff = (size_t)chunk * 4096 + ((ti * 2 + (tj >> 1)) * 64 + (2 * (tj & 1) + (g >> 1)) * 16 + fr) * 8 + 4 * (g & 1);
            if (tj > ti) { if (type == 1) *(u32x2*)(Ab + aoff) = (u32x2){0u, 0u}; continue; }
            f32x4 acc = (f32x4){0.f, 0.f, 0.f, 0.f};
            const int xoff = type == 0 ? DN_K : DN_Q;
#pragma unroll
            for (int s = 0; s < 4; ++s) { const bf16x8 a = *(const LAS bf16x8*)(lds + DN_K + (16 * tj + fr) * 272 + (32 * s + 8 * g) * 2), bb = *(const LAS bf16x8*)(lds + xoff + i * 272 + (32 * s + 8 * g) * 2); acc = mfma32(a, bb, acc); }
            float v[4];
#pragma unroll
            for (int reg = 0; reg < 4; ++reg) { const int j = 16 * tj + 4 * g + reg; const float e = __expf(fminf(gi - gc_s[j], 0.f));
                v[reg] = type == 0 ? ((i > j) ? -bi * acc[reg] * e : 0.f) : ((i >= j) ? acc[reg] * e : 0.f); }
            if (type == 1) *(u32x2*)(Ab + aoff) = (u32x2){cvt_pk(v[0], v[1]), cvt_pk(v[2], v[3])};
            else if (tj == ti) *(LAS f32x4*)(Ad + (ti * 16 + fr) * 16 + 4 * g) = (f32x4){-v[0], -v[1], -v[2], -v[3]};
            else *(LAS u32x2*)(lds + DN_ABF + i * 144 + (16 * tj + 4 * g) * 2) = (u32x2){cvt_pk(v[0], v[1]), cvt_pk(v[2], v[3])};
        }
    }
    LDS_BARRIER();
    if (wid == 0) {
        const int bb = lane >> 4, c = lane & 15;
        float t[16];
#pragma unroll
        for (int i = 0; i < 16; ++i) {
            float acc = (i == c) ? 1.0f : 0.0f;
#pragma unroll
            for (int jj = 0; jj < (i + 3) / 4; ++jj) { const f32x4 a4 = *(const LAS f32x4*)(Ad + (bb * 16 + i) * 16 + 4 * jj);
#pragma unroll
                for (int e = 0; e < 4; ++e) if (4 * jj + e < i) acc -= a4[e] * t[4 * jj + e]; }
            t[i] = acc;
            *(LAS bf16_t*)(lds + DN_TBF + ((bb * 16 + i) * 24 + c) * 2) = f2bf(acc);
        }
    } else {
        for (int it = tid - 64; it < 512; it += 448) {
            if (it < 256) { const int i = it >> 2, part = it & 3; const float e = eg_s[i];
#pragma unroll
                for (int c4 = 0; c4 < 4; ++c4) { const u32x4 qv = *(const LAS u32x4*)(lds + DN_Q + i * 272 + part * 64 + c4 * 16);
                    u32x4 o; o.x = cvt_pk(bflo(qv.x) * e, bfhi(qv.x) * e); o.y = cvt_pk(bflo(qv.y) * e, bfhi(qv.y) * e); o.z = cvt_pk(bflo(qv.z) * e, bfhi(qv.z) * e); o.w = cvt_pk(bflo(qv.w) * e, bfhi(qv.w) * e);
                    *(u32x4*)(Qd + (size_t)chunk * 8192 + (((i >> 4) * 4 + part) * 64 + c4 * 16 + (i & 15)) * 8) = o; }
            } else { const int t2 = it - 256, d = t2 & 127, ih = t2 >> 7; const float gl = gc_s[63]; const LAS bf16_t* ks = (const LAS bf16_t*)(lds + DN_K) + d;
#pragma unroll
                for (int i8 = 0; i8 < 4; ++i8) { float v[8];
#pragma unroll
                    for (int e = 0; e < 8; ++e) { const int i = 32 * ih + 8 * i8 + e; v[e] = bf2f(ks[i * 136]) * __expf(gl - gc_s[i]); }
                    *(u32x4*)(Kt + (size_t)chunk * 8192 + (((d >> 4) * 2 + ih) * 64 + i8 * 16 + (d & 15)) * 8) = (u32x4){cvt_pk(v[0], v[1]), cvt_pk(v[2], v[3]), cvt_pk(v[4], v[5]), cvt_pk(v[6], v[7])}; } }
        }
        if (tid == 64) Cd[chunk] = expf(gc_s[63]);
    }
    LDS_BARRIER();
#pragma unroll
    for (int cc = 0; cc < 2; ++cc) {
        const int ct = 2 * wid + cc; const bool isu = ct < 8;
        const LAS bf16_t* src = (const LAS bf16_t*)(lds + (isu ? DN_V : DN_K)) + 16 * (ct & 7) + fr;
        bf16x4 Xb[4];
#pragma unroll
        for (int I = 0; I < 4; ++I) {
            f32x4 acc;
#pragma unroll
            for (int reg = 0; reg < 4; ++reg) { const int i = 16 * I + 4 * g + reg; float r = bf2f(src[i * 136]) * beta_s[i]; if (!isu) r *= eg_s[i]; acc[reg] = r; }
#pragma unroll
            for (int J = 0; J < I; ++J) { const bf16x4 a = *(const LAS bf16x4*)(lds + DN_ABF + (16 * I + fr) * 144 + (16 * J + 4 * g) * 2); acc = mfma16(a, Xb[J], acc); }
            const u32x2 yw = (u32x2){cvt_pk(acc[0], acc[1]), cvt_pk(acc[2], acc[3])};
            const bf16x4 tt = *(const LAS bf16x4*)(lds + DN_TBF + ((I * 16 + fr) * 24 + 4 * g) * 2);
            const f32x4 x = mfma16(tt, __builtin_bit_cast(bf16x4, yw), (f32x4){0.f, 0.f, 0.f, 0.f});
            const u32x2 xw = (u32x2){cvt_pk(x[0], x[1]), cvt_pk(x[2], x[3])};
            Xb[I] = __builtin_bit_cast(bf16x4, xw);
            if (isu) *(u32x2*)(Uf + ((((size_t)chunk * 8 + ct) * 4 + I) * 64 + lane) * 4) = xw;
            else {
#pragma unroll
                for (int reg = 0; reg < 4; ++reg) Wb[(size_t)chunk * 8192 + ((I * 4 + ((16 * (ct - 8) + fr) >> 5)) * 64 + (((16 * (ct - 8) + fr) >> 3) & 3) * 16 + 4 * g + reg) * 8 + (fr & 7)] = (bf16_t)(reg & 1 ? (reg & 2 ? xw.y >> 16 : xw.x >> 16) : (reg & 2 ? xw.y & 0xffffu : xw.x & 0xffffu));
            }
        }
    }
    LDS_BARRIER();
}

struct ScanRegs { bf16x8 f1[4], af[2], kf[2]; u32x2 uv; float cd; };
__device__ __forceinline__ void scan_load(ScanRegs& R, const bf16_t* __restrict__ Wb, const bf16_t* __restrict__ Uf, const bf16_t* __restrict__ Qd, const bf16_t* __restrict__ Kt, const bf16_t* __restrict__ Ab, const float* __restrict__ Cd,
                                          int chunk, int wid, int lane, int fr, int g, int sl) {
    const int tt = wid & 3;
    const bf16_t* src = (wid < 4 ? Wb : Qd) + (size_t)chunk * 8192 + (tt * 4 * 64 + lane) * 8;
#pragma unroll
    for (int s = 0; s < 4; ++s) R.f1[s] = *(const bf16x8*)(src + s * 512);
    R.uv = *(const u32x2*)(Uf + ((((size_t)chunk * 8 + sl) * 4 + tt) * 64 + lane) * 4);
#pragma unroll
    for (int s = 0; s < 2; ++s) R.af[s] = *(const bf16x8*)(Ab + (size_t)chunk * 4096 + ((tt * 2 + s) * 64 + lane) * 8);
#pragma unroll
    for (int s = 0; s < 2; ++s) R.kf[s] = *(const bf16x8*)(Kt + (size_t)chunk * 8192 + ((wid * 2 + s) * 64 + lane) * 8);
    R.cd = Cd[chunk];
}
__device__ __forceinline__ void scan_step(LAS unsigned char* lds, const ScanRegs& R, f32x4& Sacc, bf16_t* __restrict__ orow, size_t ostride, int wid, int fr, int g) {
    f32x4 acc = (f32x4){0.f, 0.f, 0.f, 0.f};
#pragma unroll
    for (int s = 0; s < 4; ++s) { const bf16x8 sf = *(const LAS bf16x8*)(lds + fr * 272 + (32 * s + 8 * g) * 2); acc = mfma32(R.f1[s], sf, acc); }
    const int voff = wid < 4 ? 4352 + fr * 144 + (16 * wid + 4 * g) * 2 : 8192 + (wid * 64 + g * 16 + fr) * 8;
    *(LAS u32x2*)(lds + voff) = (u32x2){cvt_pk(bflo(R.uv.x) - acc[0], bfhi(R.uv.x) - acc[1]), cvt_pk(bflo(R.uv.y) - acc[2], bfhi(R.uv.y) - acc[3])};
    LDS_BARRIER();
    const bf16x8 v0 = *(const LAS bf16x8*)(lds + 4352 + fr * 144 + (8 * g) * 2), v1 = *(const LAS bf16x8*)(lds + 4352 + fr * 144 + (32 + 8 * g) * 2);
    Sacc = Sacc * R.cd;
    Sacc = mfma32(R.kf[0], v0, Sacc); Sacc = mfma32(R.kf[1], v1, Sacc);
    *(LAS u32x2*)(lds + fr * 272 + (16 * wid + 4 * g) * 2) = (u32x2){cvt_pk(Sacc[0], Sacc[1]), cvt_pk(Sacc[2], Sacc[3])};
    acc = mfma32(R.af[0], v0, acc); acc = mfma32(R.af[1], v1, acc);
#pragma unroll
    for (int reg = 0; reg < 4; ++reg) orow[(size_t)reg * ostride] = f2bf(acc[reg]);
    LDS_BARRIER();
}
__device__ void dn_scan_item(LAS unsigned char* lds, const bf16_t* __restrict__ Wb, const bf16_t* __restrict__ Uf, const bf16_t* __restrict__ Qd, const bf16_t* __restrict__ Kt, const bf16_t* __restrict__ Ab, const float* __restrict__ Cd,
                             bf16_t* __restrict__ Odn, bf16_t* __restrict__ dump, int item) {
    const int tid = threadIdx.x, wid = __builtin_amdgcn_readfirstlane(tid >> 6), lane = tid & 63, fr = lane & 15, g = lane >> 4;
    const int bh = (item & 7) + 8 * (item >> 6), sl = (item >> 3) & 7, b = bh >> 4, h = bh & 15;
    f32x4 Sacc = (f32x4){0.f, 0.f, 0.f, 0.f};
    *(LAS u32x2*)(lds + fr * 272 + (16 * wid + 4 * g) * 2) = (u32x2){0u, 0u};
    __syncthreads();
    const int c0 = bh * 128;
    bf16_t* obase = wid >= 4 ? Odn + ((size_t)b * SEQ + 16 * (wid - 4) + 4 * g) * 2048 + h * 128 + 16 * sl + fr : dump + ((size_t)blockIdx.x * 512 + tid) * 4;
    const size_t ostride = wid >= 4 ? 2048 : 1, ostep = wid >= 4 ? (size_t)64 * 2048 : 0;
    ScanRegs R0, R1, R2, R3, R4;
#define SLOAD(R, n) scan_load(R, Wb, Uf, Qd, Kt, Ab, Cd, c0 + (n), wid, lane, fr, g, sl)
#define SSTEP(RC, RP, n) if ((n) < 128) { if ((n) + 4 < 128) SLOAD(RP, (n) + 4); scan_step(lds, RC, Sacc, obase + (size_t)(n) * ostep, ostride, wid, fr, g); }
    SLOAD(R0, 0); SLOAD(R1, 1); SLOAD(R2, 2); SLOAD(R3, 3);
    for (int n = 0; n < 128; n += 5) {
        SSTEP(R0, R4, n) SSTEP(R1, R0, n + 1) SSTEP(R2, R1, n + 2) SSTEP(R3, R2, n + 3) SSTEP(R4, R3, n + 4)
    }
#undef SLOAD
#undef SSTEP
    __syncthreads();
}

__device__ void phase_finalize(const bf16_t* __restrict__ proj, const bf16_t* __restrict__ op, const float* __restrict__ lsep, const bf16_t* __restrict__ Odn, const float* __restrict__ dn_g, bf16_t* __restrict__ mixed) {
    const int tid = threadIdx.x, sub = tid & 15;
    f32x4 g0 = *(const f32x4*)(dn_g + sub * 8), g1 = *(const f32x4*)(dn_g + sub * 8 + 4);
    for (int base = blockIdx.x * 32; base < T_TOK * 16; base += gridDim.x * 32) {
        const int pi = base + (tid >> 4), t = pi >> 4, h = pi & 15;
        { const float l0 = lsep[((size_t)0 * T_TOK + t) * 16 + h], l1 = lsep[((size_t)1 * T_TOK + t) * 16 + h], l2 = lsep[((size_t)2 * T_TOK + t) * 16 + h];
          const float m = fmaxf(l0, fmaxf(l1, l2)); float e0 = __expf(l0 - m), e1 = __expf(l1 - m), e2 = __expf(l2 - m); const float inv = 1.0f / (e0 + e1 + e2); e0 *= inv; e1 *= inv; e2 *= inv;
          const size_t oo = (size_t)t * 2048 + h * 128 + sub * 8;
          const u32x4 a0 = __builtin_nontemporal_load((const u32x4*)(op + oo)), a1 = __builtin_nontemporal_load((const u32x4*)(op + (size_t)T_TOK * 2048 + oo)), a2 = __builtin_nontemporal_load((const u32x4*)(op + (size_t)2 * T_TOK * 2048 + oo));
          const u32x4 gt = __builtin_nontemporal_load((const u32x4*)(proj + (size_t)t * NPROJ + 6144 + h * 128 + sub * 8));
          u32x4 o;
#define MIXW(F) { const float lo = (e0 * bflo(a0.F) + e1 * bflo(a1.F) + e2 * bflo(a2.F)) * silu_f(bflo(gt.F)), hi = (e0 * bfhi(a0.F) + e1 * bfhi(a1.F) + e2 * bfhi(a2.F)) * silu_f(bfhi(gt.F)); o.F = cvt_pk(lo, hi); }
          MIXW(x) MIXW(y) MIXW(z) MIXW(w)
#undef MIXW
          *(u32x4*)(mixed + (size_t)t * DMODEL + h * 128 + sub * 8) = o; }
        { const u32x4 ov = __builtin_nontemporal_load((const u32x4*)(Odn + (size_t)t * 2048 + h * 128 + sub * 8));
          float v[8] = {bflo(ov.x), bfhi(ov.x), bflo(ov.y), bfhi(ov.y), bflo(ov.z), bfhi(ov.z), bflo(ov.w), bfhi(ov.w)};
          float ss = 0.f;
#pragma unroll
          for (int e = 0; e < 8; ++e) ss += v[e] * v[e];
          ss += __shfl_xor(ss, 1); ss += __shfl_xor(ss, 2); ss += __shfl_xor(ss, 4); ss += __shfl_xor(ss, 8);
          const float rstd = rsqrtf(ss * (1.0f / 128.0f) + 1e-6f);
          const u32x4 gt = __builtin_nontemporal_load((const u32x4*)(proj + (size_t)t * NPROJ + 14336 + h * 128 + sub * 8));
          u32x4 o;
          o.x = cvt_pk(v[0] * rstd * g0[0] * silu_f(bflo(gt.x)), v[1] * rstd * g0[1] * silu_f(bfhi(gt.x)));
          o.y = cvt_pk(v[2] * rstd * g0[2] * silu_f(bflo(gt.y)), v[3] * rstd * g0[3] * silu_f(bfhi(gt.y)));
          o.z = cvt_pk(v[4] * rstd * g1[0] * silu_f(bflo(gt.z)), v[5] * rstd * g1[1] * silu_f(bfhi(gt.z)));
          o.w = cvt_pk(v[6] * rstd * g1[2] * silu_f(bflo(gt.w)), v[7] * rstd * g1[3] * silu_f(bfhi(gt.w)));
          *(u32x4*)(mixed + (size_t)t * DMODEL + 2048 + h * 128 + sub * 8) = o; }
    }
}

__device__ void phase_final_norm(const bf16_t* __restrict__ H, float* __restrict__ out, const float* __restrict__ g) {
    const int wid = threadIdx.x >> 6, lane = threadIdx.x & 63;
    const int gw = blockIdx.x * 8 + wid, nw = gridDim.x * 8;
    for (int row = gw; row < T_TOK; row += nw) {
        const u32x4* hr = (const u32x4*)(H + (size_t)row * DMODEL);
        f32x4* orow = (f32x4*)(out + (size_t)row * DMODEL);
        u32x4 v[8]; float ss = 0.f;
#pragma unroll
        for (int i = 0; i < 8; ++i) { v[i] = __builtin_nontemporal_load(hr + i * 64 + lane);
            ss += bflo(v[i].x) * bflo(v[i].x) + bfhi(v[i].x) * bfhi(v[i].x) + bflo(v[i].y) * bflo(v[i].y) + bfhi(v[i].y) * bfhi(v[i].y)
                + bflo(v[i].z) * bflo(v[i].z) + bfhi(v[i].z) * bfhi(v[i].z) + bflo(v[i].w) * bflo(v[i].w) + bfhi(v[i].w) * bfhi(v[i].w); }
        ss = wave_sum(ss);
        const float rstd = rsqrtf(ss * (1.0f / DMODEL) + 1e-6f);
#pragma unroll
        for (int i = 0; i < 8; ++i) { const int e = (i * 64 + lane) * 2; const f32x4 g0 = ((const f32x4*)g)[e], g1 = ((const f32x4*)g)[e + 1];
            __builtin_nontemporal_store((f32x4){bflo(v[i].x), bfhi(v[i].x), bflo(v[i].y), bfhi(v[i].y)} * rstd * g0, orow + e);
            __builtin_nontemporal_store((f32x4){bflo(v[i].z), bfhi(v[i].z), bflo(v[i].w), bfhi(v[i].w)} * rstd * g1, orow + e + 1); }
    }
}

__global__ void __launch_bounds__(512, 2) mega_fwd(Params p) {
    extern __shared__ __attribute__((aligned(16))) unsigned char shm[];
    LAS unsigned char* lds = (LAS unsigned char*)shm;
    cg::grid_group grid = cg::this_grid();
    unsigned char* ws = p.ws;
    bf16_t* xn = (bf16_t*)(ws + OFF_XN); bf16_t* WinT = (bf16_t*)(ws + OFF_WINT); bf16_t* WoutT = (bf16_t*)(ws + OFF_WOUTT); bf16_t* proj = (bf16_t*)(ws + OFF_PROJ);
    float* gate = (float*)(ws + OFF_GATE); bf16_t* mixed = (bf16_t*)(ws + OFF_MIXED); bf16_t* Ab = (bf16_t*)(ws + OFF_AB); float* lsep = (float*)(ws + OFF_LSE); float* Cd = (float*)(ws + OFF_CD);
    bf16_t* Wb = (bf16_t*)(ws + OFF_WB); bf16_t* Ub = (bf16_t*)(ws + OFF_UB); bf16_t* Qd = (bf16_t*)(ws + OFF_QD); bf16_t* Kt = (bf16_t*)(ws + OFF_KT);
    bf16_t* op = (bf16_t*)((unsigned char*)p.out + OUT_OP); bf16_t* Odn = (bf16_t*)((unsigned char*)p.out + OUT_ODN);
    const int G = (int)gridDim.x, c = (int)blockIdx.x;
    volatile LAS unsigned* xst = (volatile LAS unsigned*)(lds + 131072);
    if (threadIdx.x == 0) { xst[0] = 0u; xst[1] = 0u; }
    __syncthreads();
    XcdBarrier xb = xcd_barrier_post((unsigned*)(ws + WS_BAR), xst);

    if (p.mask & 1) for (int rep = 0; rep < REP_P0; ++rep) {
        phase_rmsnorm_x(p.x, p.norm_g, xn);
        phase_transpose(lds, p.w_in, DMODEL, NIN, NIN, WinT);
        phase_transpose(lds, p.w_out, DMODEL, DMODEL, DMODEL, WoutT);
    }
    if (p.coop == 2) grid.sync();
    if (p.coop) xcd_barrier(xb);
    if (p.mask & 2) {
        __syncthreads();
        for (int rb = c; rb < T_TOK / 64; rb += G) gate_gemm(lds, xn, WinT, gate, rb);
        pg8::Gemm g{xn, WinT, T_TOK, NPROJ, DMODEL}; RepOrder S; S.init(T_TOK, NPROJ, G, c); S.reps = REP_G1; EpiProj E{proj, gate};
        pg8::gemm_phase<EpiProj, RepOrder, false>(lds, g, S, E, nullptr);
        __syncthreads();
    }
    if (p.coop) xcd_barrier(xb);
    if (p.mask & 4) {
        { const int per = (N_ATTN_TASKS + G - 1) / G; for (int rep = 0; rep < REP_ATT; ++rep) attn_phase(lds, proj, op, lsep, c * per, (c + 1) * per < N_ATTN_TASKS ? (c + 1) * per : N_ATTN_TASKS); }
        for (int rep = 0; rep < REP_PREP; ++rep) { const int per = (4096 + G - 1) / G; int hprev = -1;
            const int ch0 = c * per, ch1 = (c + 1) * per < 4096 ? (c + 1) * per : 4096;
            PrepPre P;
            if (ch0 < ch1) dn_prep_prefetch(P, proj, gate, p.a_log, p.dt_bias, ch0);
            for (int chunk = ch0; chunk < ch1; ++chunk) { const int hh = (chunk >> 7) & 15;
                if (hh != hprev) { dn_stage_convw(lds, p.conv_w, hh); hprev = hh; }
                dn_prep_chunk(lds, proj, gate, p.a_log, p.dt_bias, Wb, Ub, Qd, Kt, Ab, Cd, chunk, chunk + 1 < ch1 ? chunk + 1 : -1, P); }
            __syncthreads(); }
    }
    if (p.coop) xcd_barrier(xb);
    if (p.mask & 8) {
        for (int rep = 0; rep < REP_SCAN; ++rep) for (int item = c; item < 256; item += G) dn_scan_item(lds, Wb, Ub, Qd, Kt, Ab, Cd, Odn, (bf16_t*)(ws + WS_END), item);
    }
    if (p.coop) xcd_barrier(xb);
    if (p.mask & 16) for (int rep = 0; rep < REP_FIN; ++rep) phase_finalize(proj, op, lsep, Odn, p.dn_norm_g, mixed);
    if (p.coop) xcd_barrier(xb);
    if (p.mask & 32) {
        __syncthreads();
        pg8::Gemm g{mixed, WoutT, T_TOK, DMODEL, DMODEL}; pg8::StaticOrder S; S.init(T_TOK, DMODEL, G, c); EpiResidBf E{proj  , p.x};
        pg8::gemm_phase<EpiResidBf, pg8::StaticOrder, false>(lds, g, S, E, nullptr);
        __syncthreads();
    }
    if (p.coop) xcd_barrier(xb);
    if (p.mask & 64) phase_final_norm(proj, p.out, p.final_g);
}

extern "C" void kernel_launch(void* const* d_in, const int* in_sizes, int n_in, void* d_out, int out_size, void* d_ws, size_t ws_size, hipStream_t stream) {
    static int grid = 0;
    if (grid == 0) {
        if (n_in != 9 || out_size != T_TOK * DMODEL || ws_size < WS_BAR + XCD_BAR_WORDS * 4) { fprintf(stderr, "kernel_launch: unexpected shapes (n_in %d out %d ws %zu)\n", n_in, out_size, ws_size); grid = -1; return; }
        int dev = 0, cus = 0, per_cu = 0;
        hipGetDevice(&dev); hipDeviceGetAttribute(&cus, hipDeviceAttributeMultiprocessorCount, dev);
        if (hipFuncSetAttribute((const void*)mega_fwd, hipFuncAttributeMaxDynamicSharedMemorySize, LDS_BYTES) != hipSuccess) { fprintf(stderr, "kernel_launch: hipFuncSetAttribute failed\n"); grid = -1; return; }
        if (hipOccupancyMaxActiveBlocksPerMultiprocessor(&per_cu, (const void*)mega_fwd, 512, LDS_BYTES) != hipSuccess || per_cu < 1) { fprintf(stderr, "kernel_launch: occupancy query gives %d\n", per_cu); per_cu = 1; }
        (void)hipGetLastError();
        grid = cus * 1;
    }
    if (grid < 0) return;
    if (hipMemsetAsync((char*)d_ws + WS_BAR, 0, XCD_BAR_WORDS * 4, stream) != hipSuccess) { fprintf(stderr, "kernel_launch: memset of barrier words failed\n"); return; }
    Params p{};
    p.x = (const float*)d_in[0]; p.norm_g = (const float*)d_in[1]; p.w_in = (const float*)d_in[2]; p.conv_w = (const float*)d_in[3]; p.a_log = (const float*)d_in[4];
    p.dt_bias = (const float*)d_in[5]; p.dn_norm_g = (const float*)d_in[6]; p.w_out = (const float*)d_in[7]; p.final_g = (const float*)d_in[8];
    p.out = (float*)d_out; p.ws = (unsigned char*)d_ws;
#if MK_COOP
    p.mask = 127; p.coop = 1;
    void* args[] = {&p};
    hipError_t e = hipLaunchCooperativeKernel((const void*)mega_fwd, dim3(grid), dim3(512), args, LDS_BYTES, stream);
    if (e != hipSuccess) fprintf(stderr, "cooperative launch failed: %s (grid %d)\n", hipGetErrorString(e), grid);
#else
    p.coop = 0;
    for (int ph = 0; ph < 7; ++ph) { p.mask = 1 << ph; hipLaunchKernelGGL(mega_fwd, dim3(grid), dim3(512), LDS_BYTES, stream, p); }
#endif
}
```

```cpp
#include <hip/hip_runtime.h>
#include <hip/hip_cooperative_groups.h>
#include <cstdio>
namespace cg = cooperative_groups;

#ifndef MK_COOP
#define MK_COOP 1
#endif

#ifndef REP_P0
#define REP_P0 1
#endif
#ifndef REP_G1
#define REP_G1 1
#endif
#ifndef REP_ATT
#define REP_ATT 1
#endif
#ifndef REP_PREP
#define REP_PREP 1
#endif
#ifndef REP_SCAN
#define REP_SCAN 1
#endif
#ifndef REP_FIN
#define REP_FIN 1
#endif
namespace pg8 {
#define PG8_LAS __attribute__((address_space(3)))
typedef unsigned short bf16_t;
typedef short bf16x8 __attribute__((ext_vector_type(8)));
typedef float f32x4 __attribute__((ext_vector_type(4)));
typedef unsigned u32x4 __attribute__((ext_vector_type(4)));
constexpr int BM = 256, BK = 64, HALF = 128, HTB = HALF * BK * 2  , STAGE_BYTES = 8 * HTB, NXCD = 8, WGM = 8;

__host__ __device__ __forceinline__ int lds_byte(int r, int c) { const int st = (r >> 4) * 2 + (c >> 5), rr = r & 15, cc = c & 31, ob = rr * 64 + cc * 2; return st * 1024 + (ob ^ (((ob >> 9) & 1) << 5)); }
__host__ __device__ __forceinline__ void stage_rc(int b, int& R, int& C) { const int st = b / 1024, sb = b % 1024, swz = sb ^ (((sb >> 9) & 1) << 5); R = (st >> 1) * 16 + swz / 64; C = (st & 1) * 32 + (swz % 64) / 2; }
__host__ __device__ __forceinline__ int perm32(int rho) { const int n = rho >> 4, i = rho & 15; return 8 * (i >> 2) + 4 * n + (i & 3); }

struct Unit { int pm, pn; };
struct Gemm { const bf16_t* A; const bf16_t* Bt; int M, N, K; };

struct StaticOrder {
    int nM, nN, nwg, G, c;
    __host__ __device__ void init(int M, int N, int G_, int c_) { nM = M / BM; nN = N / BM; nwg = nM * nN; G = G_; c = c_; }
    __host__ __device__ bool next(int i, Unit& u) const {
        const long L = (long)i * G + c; if (L >= nwg) return false;
        int wgid = (int)L; { const int q = nwg / NXCD, r = nwg % NXCD, xcd = wgid % NXCD, off = wgid / NXCD; wgid = (xcd < r ? xcd * (q + 1) : r * (q + 1) + (xcd - r) * q) + off; }
        const int nig = WGM * nN, gid = wgid / nig, fm = gid * WGM, gsz = (nM - fm) < WGM ? (nM - fm) : WGM;
        u.pm = fm + ((wgid % nig) % gsz); u.pn = (wgid % nig) / gsz; return true;
    }
    __device__ __forceinline__ void a_ready(const Unit&) const {}
    __device__ __forceinline__ void done(const Unit&) const {}
};
template <class Epi, class Sched, bool STAMP = false>
__device__ __forceinline__ void gemm_phase(PG8_LAS unsigned char* lds, const Gemm g, const Sched& S, const Epi& E, unsigned long long* stamps) {
    const int tid = threadIdx.x, wid = __builtin_amdgcn_readfirstlane(tid >> 6), lane = tid & 63, wr = wid >> 2, wc = wid & 3, fr = lane & 15, fq = lane >> 4;
    const int K = g.K, nt = K / BK;
    int ts_lo = 0, ts_hi = 0, nts = 0; const unsigned long long rt_entry = STAMP ? (unsigned long long)wall_clock64() : 0ull;
#define PG8_STAMP() do { if (STAMP && wid == 0 && nts < 64) { const unsigned long long _c = (unsigned long long)clock64(); \
        ts_lo = (lane == nts) ? (int)(unsigned)_c : ts_lo; ts_hi = (lane == nts) ? (int)(unsigned)(_c >> 32) : ts_hi; ++nts; } } while (0)
    PG8_STAMP();
    unsigned voffA[2], voffB[2];
#pragma unroll
    for (int i = 0; i < 2; ++i) { int R, C; stage_rc(tid * 16 + i * 8192, R, C); const int Rb = Epi::PERM ? ((R & ~31) + perm32(R & 31)) : R;
        voffA[i] = (unsigned)(R * K + C) * 2u; voffB[i] = (unsigned)(Rb * K + C) * 2u; }
    const size_t kstep = (size_t)(BK * 2);
    const size_t hstep = (size_t)HALF * K * 2;
    const size_t tstep = 2 * hstep;
    const unsigned ldsw = (unsigned)wid * 1024u;
    const int aoff = lds_byte(wr * 64 + fr, fq * 8), boff = lds_byte(wc * 32 + fr, fq * 8);
#define PG8_SA(b, h) (((b) * 2 + (h)) * HTB)
#define PG8_SB(b, h) ((4 + (b) * 2 + (h)) * HTB)
#define PG8_STAGE(bufoff, gbase, voff) do { _Pragma("unroll") for (int _i = 0; _i < 2; ++_i) \
        __builtin_amdgcn_global_load_lds((const unsigned*)((const char*)(gbase) + (voff)[_i]), (PG8_LAS unsigned*)(lds + (bufoff) + ldsw + _i * 8192), 16, 0, 0); } while (0)
#define PG8_LDA(dst, b, h) do { _Pragma("unroll") for (int m = 0; m < 4; ++m) _Pragma("unroll") for (int k = 0; k < 2; ++k) dst[m][k] = *(const PG8_LAS bf16x8*)(lds + PG8_SA(b, h) + aoff + m * 2048 + k * 1024); } while (0)
#define PG8_LDB(dst, b, h) do { _Pragma("unroll") for (int n = 0; n < 2; ++n) _Pragma("unroll") for (int k = 0; k < 2; ++k) dst[n][k] = *(const PG8_LAS bf16x8*)(lds + PG8_SB(b, h) + boff + n * 2048 + k * 1024); } while (0)
#define PG8_MMA(ai, bj, At, Bt) do { __builtin_amdgcn_s_setprio(1); _Pragma("unroll") for (int m = 0; m < 4; ++m) _Pragma("unroll") for (int n = 0; n < 2; ++n) _Pragma("unroll") for (int k = 0; k < 2; ++k) \
        acc[ai][bj][m][n] = __builtin_amdgcn_mfma_f32_16x16x32_bf16(Bt[n][k], At[m][k], acc[ai][bj][m][n], 0, 0, 0); __builtin_amdgcn_s_setprio(0); } while (0)
#define PG8_WAIT_V(n) asm volatile("s_waitcnt vmcnt(" #n ")" ::: "memory")
#define PG8_WAIT_L(n) asm volatile("s_waitcnt lgkmcnt(" #n ")" ::: "memory")
#define PG8_BAR __builtin_amdgcn_s_barrier()
#define PG8_SCHED __builtin_amdgcn_sched_barrier(0)
    Unit cur, nxt; int ui = 0;
    if (!S.next(0, cur)) return;
    f32x4 acc[2][2][4][2];
#pragma unroll
    for (int a = 0; a < 2; ++a)
#pragma unroll
        for (int b = 0; b < 2; ++b)
#pragma unroll
            for (int m = 0; m < 4; ++m)
#pragma unroll
                for (int n = 0; n < 2; ++n) acc[a][b][m][n] = (f32x4){0.f, 0.f, 0.f, 0.f};
    bf16x8 At[4][2], B0[2][2], B1[2][2];
    const char* cA = (const char*)g.A + (size_t)cur.pm * tstep; const char* cB = (const char*)g.Bt + (size_t)cur.pn * tstep;
    S.a_ready(cur);
    PG8_STAGE(PG8_SB(0, 0), cB, voffB); PG8_STAGE(PG8_SA(0, 0), cA, voffA); PG8_STAGE(PG8_SB(0, 1), cB + hstep, voffB); PG8_STAGE(PG8_SA(0, 1), cA + hstep, voffA);
    if (wr == 1) PG8_BAR;
    PG8_WAIT_V(4); PG8_BAR;
    PG8_STAGE(PG8_SB(1, 0), cB + kstep, voffB); PG8_STAGE(PG8_SA(1, 0), cA + kstep, voffA); PG8_STAGE(PG8_SB(1, 1), cB + hstep + kstep, voffB);
    PG8_WAIT_V(6); PG8_BAR;
    PG8_STAMP();
    for (;;) {
        const bool has_next = S.next(ui + 1, nxt);
        const char* nA = has_next ? (const char*)g.A + (size_t)nxt.pm * tstep : cA; const char* nB = has_next ? (const char*)g.Bt + (size_t)nxt.pn * tstep : cB;
        for (int t = 0; t < nt; t += 2) {
            const bool last = (t == nt - 2);
            const char* a1 = cA + (size_t)(t + 1) * kstep;
            const char* a2 = last ? nA : cA + (size_t)(t + 2) * kstep; const char* b2 = last ? nB : cB + (size_t)(t + 2) * kstep;
            const char* a3 = a2 + kstep; const char* b3 = b2 + kstep;
            if (last && has_next) S.a_ready(nxt);
            PG8_LDB(B0, 0, 0); PG8_SCHED; PG8_LDA(At, 0, 0); PG8_STAGE(PG8_SA(1, 1), a1 + hstep, voffA);
            PG8_WAIT_L(8); PG8_BAR; PG8_WAIT_L(0); PG8_MMA(0, 0, At, B0); PG8_BAR; PG8_SCHED;
            PG8_LDB(B1, 0, 1); PG8_STAGE(PG8_SB(0, 0), b2, voffB);
            PG8_BAR; PG8_WAIT_L(0); PG8_MMA(0, 1, At, B1); PG8_BAR;
            PG8_LDA(At, 0, 1); PG8_STAGE(PG8_SA(0, 0), a2, voffA);
            PG8_BAR; PG8_WAIT_L(0); PG8_MMA(1, 0, At, B0); PG8_BAR; PG8_SCHED;
            PG8_STAGE(PG8_SB(0, 1), b2 + hstep, voffB);
            PG8_WAIT_V(6); PG8_BAR; PG8_MMA(1, 1, At, B1); PG8_BAR;
            PG8_LDB(B0, 1, 0); PG8_SCHED; PG8_LDA(At, 1, 0); PG8_STAGE(PG8_SA(0, 1), a2 + hstep, voffA);
            PG8_WAIT_L(8); PG8_BAR; PG8_WAIT_L(0); PG8_MMA(0, 0, At, B0); PG8_BAR; PG8_SCHED;
            PG8_LDB(B1, 1, 1); PG8_STAGE(PG8_SB(1, 0), b3, voffB);
            PG8_BAR; PG8_WAIT_L(0); PG8_MMA(0, 1, At, B1); PG8_BAR;
            PG8_LDA(At, 1, 1); PG8_STAGE(PG8_SA(1, 0), a3, voffA);
            PG8_BAR; PG8_WAIT_L(0); PG8_MMA(1, 0, At, B0); PG8_BAR; PG8_SCHED;
            PG8_STAGE(PG8_SB(1, 1), b3 + hstep, voffB);
            PG8_WAIT_V(6); PG8_BAR; PG8_MMA(1, 1, At, B1); PG8_BAR;
        }
        PG8_STAMP();
        if constexpr (!Epi::AFTER_DRAIN) { E(acc, cur, wr, wc, fr, fq); S.done(cur); }
        PG8_STAMP();
        if (!has_next) break;
#pragma unroll
        for (int a = 0; a < 2; ++a)
#pragma unroll
            for (int b = 0; b < 2; ++b)
#pragma unroll
                for (int m = 0; m < 4; ++m)
#pragma unroll
                    for (int n = 0; n < 2; ++n) acc[a][b][m][n] = (f32x4){0.f, 0.f, 0.f, 0.f};
        cur = nxt; cA = nA; cB = nB; ++ui;
    }
    PG8_WAIT_V(0);
    if (wr == 0) PG8_BAR;
    PG8_BAR;
    if constexpr (Epi::AFTER_DRAIN) { E.fused(acc, cur, wr, wc, fr, fq, lds, wid, lane); S.done(cur); }
    PG8_STAMP();
    if (STAMP && wid == 0) { stamps[lane] = lane < nts ? (((unsigned long long)(unsigned)ts_hi << 32) | (unsigned)ts_lo) : 0ull;
        if (lane == 62) stamps[62] = rt_entry; if (lane == 63) stamps[63] = (unsigned long long)wall_clock64(); }
#undef PG8_STAMP
#undef PG8_SA
#undef PG8_SB
#undef PG8_STAGE
#undef PG8_LDA
#undef PG8_LDB
#undef PG8_MMA
#undef PG8_WAIT_V
#undef PG8_WAIT_L
#undef PG8_BAR
#undef PG8_SCHED
}
}

#define LAS __attribute__((address_space(3)))
#define XB_TMO      128
#define XB_XCNT(j)  (256  + 64 * (j))
#define XB_XSUB(j)  (1280 + 64 * (j))
#define XB_XGEN(j)  (2304 + 64 * (j))
#define XB_TOP      3328
#define XB_TOPGEN   3392
#define XCD_BAR_WORDS 3456
#define XB_SPIN_CAP (1u << 18)

__device__ __forceinline__ unsigned xb_ld(unsigned* p)              { return __hip_atomic_load(p, __ATOMIC_RELAXED, __HIP_MEMORY_SCOPE_AGENT); }
__device__ __forceinline__ unsigned xb_add(unsigned* p, unsigned v) { return __hip_atomic_fetch_add(p, v, __ATOMIC_RELAXED, __HIP_MEMORY_SCOPE_AGENT); }
__device__ __forceinline__ unsigned xb_xcc_id() { return (unsigned)__builtin_amdgcn_s_getreg((3 << 11) | 20) & 0xFu; }
#define XB_SPIN(cond, bar) do { unsigned _sp = 0; while (cond) { __builtin_amdgcn_s_sleep(1); \
    if ((++_sp & 255u) == 0u) { if (xb_ld(&(bar)[XB_TMO])) break; if (_sp > XB_SPIN_CAP) { atomicAdd(&(bar)[XB_TMO], 1u); break; } } } } while (0)

struct XcdBarrier {
    unsigned* bar; unsigned x;
    volatile LAS unsigned* st;
};

__device__ __forceinline__ XcdBarrier xcd_barrier_post(unsigned* bar, volatile LAS unsigned* st) {
    XcdBarrier b; b.bar = bar; b.x = xb_xcc_id(); b.st = st;
    if (threadIdx.x == 0) (void)xb_add(&bar[XB_XCNT(b.x)], 1u);
    return b;
}
__device__ __forceinline__ void xcd_barrier_complete(unsigned* bar, unsigned x, unsigned& nloc, unsigned& nx) {
    const unsigned G = gridDim.x * gridDim.y * gridDim.z;
    unsigned sum, cnt, mine, sp = 0u;
    for (;;) {
        sum = 0u; cnt = 0u; mine = 0u;
#pragma unroll
        for (unsigned j = 0; j < 16; ++j) { const unsigned c = xb_ld(&bar[XB_XCNT(j)]); sum += c; cnt += (c > 0u) ? 1u : 0u; mine = (j == x) ? c : mine; }
        if (sum == G) break;
        __builtin_amdgcn_s_sleep(1);
        if ((++sp & 255u) == 0u) { if (xb_ld(&bar[XB_TMO])) break; if (sp > XB_SPIN_CAP) { atomicAdd(&bar[XB_TMO], 1u); break; } }
    }
    nloc = mine > 0u ? mine : 1u; nx = cnt > 0u ? cnt : 1u;
}

__device__ __forceinline__ void xcd_barrier(const XcdBarrier& b) {
    asm volatile("s_waitcnt vmcnt(0)" ::: "memory");
    __syncthreads();
    if (threadIdx.x == 0) {
        unsigned* bar = b.bar;
        __builtin_amdgcn_s_waitcnt(0);
        unsigned nloc = b.st[0], nx = b.st[1];
        if (nloc == 0u) { xcd_barrier_complete(bar, b.x, nloc, nx); b.st[0] = nloc; b.st[1] = nx; }
        const unsigned old = xb_add(&bar[XB_XSUB(b.x)], 1u);
        const unsigned gen = old / nloc;
        if (old + 1u == (gen + 1u) * nloc) {
            __builtin_amdgcn_fence(__ATOMIC_RELEASE, "agent");
            asm volatile("s_waitcnt vmcnt(0)" ::: "memory");
            const unsigned og = xb_add(&bar[XB_TOP], 1u);
            const unsigned tg = og / nx;
            if (og + 1u == (tg + 1u) * nx) xb_add(&bar[XB_TOPGEN], 1u);
            else XB_SPIN(xb_ld(&bar[XB_TOPGEN]) == tg, bar);
            __builtin_amdgcn_fence(__ATOMIC_ACQUIRE, "agent");
            xb_add(&bar[XB_XGEN(b.x)], 1u);
            asm volatile("s_waitcnt vmcnt(0)" ::: "memory");
        } else {
            XB_SPIN(xb_ld(&bar[XB_XGEN(b.x)]) == gen, bar);
            __builtin_amdgcn_fence(__ATOMIC_ACQUIRE, "agent");
            asm volatile("s_waitcnt vmcnt(0)" ::: "memory");
        }
    }
    __syncthreads();
}


typedef unsigned short bf16_t;
typedef short bf16x8 __attribute__((ext_vector_type(8)));
typedef short bf16x4 __attribute__((ext_vector_type(4)));
typedef float f32x4 __attribute__((ext_vector_type(4)));
typedef unsigned u32x4 __attribute__((ext_vector_type(4)));
typedef unsigned u32x2 __attribute__((ext_vector_type(2)));

constexpr int T_TOK = 16384, DMODEL = 4096, SEQ = 8192, NPROJ = 16384, NIN = 16416, NPAD = 16640;
constexpr int LDS_BYTES = 131072 + 16;
constexpr size_t OFF_XN = 0, OFF_WINT = 134217728ull, OFF_WOUTT = 270532608ull, OFF_PROJ = 304087040ull, OFF_GATE = 840957952ull,
                 OFF_MIXED = 843055104ull, OFF_AB = 977272832ull, OFF_LSE = 1010827264ull, OFF_CD = 1013972992ull, WS_END = 1013989376ull, WS_BAR = WS_END + (8ull << 20);
constexpr size_t OFF_WB = 0, OFF_UB = 67108864ull, OFF_QD = 134217728ull, OFF_KT = 201326592ull;
constexpr size_t OUT_OP = 0, OUT_ODN = 201326592ull;

struct Params {
    const float* x; const float* norm_g; const float* w_in; const float* conv_w; const float* a_log; const float* dt_bias; const float* dn_norm_g; const float* w_out; const float* final_g;
    float* out; unsigned char* ws; int mask; int coop;
};

typedef __bf16 bf16v2_t __attribute__((ext_vector_type(2)));
typedef float f32v2_t __attribute__((ext_vector_type(2)));
__device__ __forceinline__ unsigned cvt_pk(float lo, float hi) { f32v2_t v = {lo, hi}; bf16v2_t b = __builtin_convertvector(v, bf16v2_t); return __builtin_bit_cast(unsigned, b); }
__device__ __forceinline__ float bflo(unsigned w) { return __uint_as_float(w << 16); }
__device__ __forceinline__ float bfhi(unsigned w) { return __uint_as_float(w & 0xffff0000u); }
__device__ __forceinline__ float bf2f(bf16_t v) { return __uint_as_float(((unsigned)v) << 16); }
__device__ __forceinline__ bf16_t f2bf(float f) { return (bf16_t)(cvt_pk(f, 0.f) & 0xffffu); }
__device__ __forceinline__ float silu_f(float v) { return v / (1.0f + __expf(-v)); }
__device__ __forceinline__ f32x4 mfma32(bf16x8 a, bf16x8 b, f32x4 c) { return __builtin_amdgcn_mfma_f32_16x16x32_bf16(a, b, c, 0, 0, 0); }
__device__ __forceinline__ f32x4 mfma16(bf16x4 a, bf16x4 b, f32x4 c) { return __builtin_amdgcn_mfma_f32_16x16x16bf16_1k(a, b, c, 0, 0, 0); }

struct EpiProj {
    static constexpr bool PERM = true, AFTER_DRAIN = false;
    bf16_t* O; float* gate;
    __device__ __forceinline__ void operator()(const f32x4 (&acc)[2][2][4][2], const pg8::Unit& u, int wr, int wc, int fr, int fq) const {
        const int row0 = u.pm * 256 + wr * 64 + fr;
        if (u.pn < 64) {
            const int col0 = u.pn * 256 + wc * 32 + 8 * fq;
#pragma unroll
            for (int ai = 0; ai < 2; ++ai)
#pragma unroll
                for (int m = 0; m < 4; ++m) { bf16_t* rowp = O + (size_t)(row0 + ai * 128 + m * 16) * NPROJ + col0;
#pragma unroll
                    for (int bj = 0; bj < 2; ++bj) { const f32x4 v0 = acc[ai][bj][m][0], v1 = acc[ai][bj][m][1];
                        u32x4 w; w.x = cvt_pk(v0[0], v0[1]); w.y = cvt_pk(v0[2], v0[3]); w.z = cvt_pk(v1[0], v1[1]); w.w = cvt_pk(v1[2], v1[3]);
                        *(u32x4*)(rowp + bj * 128) = w; } }
        } else if (wc == 0) {
#pragma unroll
            for (int ai = 0; ai < 2; ++ai)
#pragma unroll
                for (int m = 0; m < 4; ++m) { float* gp = gate + (size_t)(row0 + ai * 128 + m * 16) * 32 + 8 * fq;
                    *(f32x4*)gp = acc[ai][0][m][0]; *(f32x4*)(gp + 4) = acc[ai][0][m][1]; }
        }
    }
};
struct EpiResid {
    static constexpr bool PERM = false, AFTER_DRAIN = false;
    float* C; const float* X;
    __device__ __forceinline__ void operator()(const f32x4 (&acc)[2][2][4][2], const pg8::Unit& u, int wr, int wc, int fr, int fq) const {
        const int row0 = u.pm * 256 + wr * 64 + fr, col0 = u.pn * 256 + wc * 32 + 4 * fq;
#pragma unroll
        for (int ai = 0; ai < 2; ++ai)
#pragma unroll
            for (int m = 0; m < 4; ++m) { const size_t off = (size_t)(row0 + ai * 128 + m * 16) * DMODEL + col0;
#pragma unroll
                for (int bj = 0; bj < 2; ++bj)
#pragma unroll
                    for (int n = 0; n < 2; ++n) { const f32x4 xv = *(const f32x4*)(X + off + bj * 128 + n * 16); *(f32x4*)(C + off + bj * 128 + n * 16) = acc[ai][bj][m][n] + xv; } }
    }
};

struct EpiResidBf {
    static constexpr bool PERM = true, AFTER_DRAIN = false;
    bf16_t* H; const float* X;
    __device__ __forceinline__ void operator()(const f32x4 (&acc)[2][2][4][2], const pg8::Unit& u, int wr, int wc, int fr, int fq) const {
        const int row0 = u.pm * 256 + wr * 64 + fr, col0 = u.pn * 256 + wc * 32 + 8 * fq;
#pragma unroll
        for (int ai = 0; ai < 2; ++ai)
#pragma unroll
            for (int m = 0; m < 4; ++m) { const size_t off = (size_t)(row0 + ai * 128 + m * 16) * DMODEL + col0;
#pragma unroll
                for (int bj = 0; bj < 2; ++bj) { const f32x4 x0 = __builtin_nontemporal_load((const f32x4*)(X + off + bj * 128)), x1 = __builtin_nontemporal_load((const f32x4*)(X + off + bj * 128 + 4));
                    const f32x4 v0 = acc[ai][bj][m][0] + x0, v1 = acc[ai][bj][m][1] + x1;
                    u32x4 w; w.x = cvt_pk(v0[0], v0[1]); w.y = cvt_pk(v0[2], v0[3]); w.z = cvt_pk(v1[0], v1[1]); w.w = cvt_pk(v1[2], v1[3]);
                    *(u32x4*)(H + off + bj * 128) = w; } }
    }
};
struct RepOrder : pg8::StaticOrder {
    int reps;
    __device__ bool next(int i, pg8::Unit& u) const {
        const long L = (long)i * G + c; if (L >= (long)nwg * reps) return false;
        int wgid = (int)(L % nwg); { const int q = nwg / pg8::NXCD, r = nwg % pg8::NXCD, xcd = wgid % pg8::NXCD, off = wgid / pg8::NXCD; wgid = (xcd < r ? xcd * (q + 1) : r * (q + 1) + (xcd - r) * q) + off; }
        const int nig = pg8::WGM * nN, gid = wgid / nig, fm = gid * pg8::WGM, gsz = (nM - fm) < pg8::WGM ? (nM - fm) : pg8::WGM;
        u.pm = fm + ((wgid % nig) % gsz); u.pn = nN - 1 - (wgid % nig) / gsz; return true;
    }
};
__device__ __forceinline__ float wave_sum(float v) {
#pragma unroll
    for (int o = 32; o >= 1; o >>= 1) v += __shfl_xor(v, o);
    return v;
}
__device__ void phase_rmsnorm_x(const float* __restrict__ x, const float* __restrict__ g, bf16_t* __restrict__ xn) {
    const int wid = threadIdx.x >> 6, lane = threadIdx.x & 63;
    const int gw = blockIdx.x * 8 + wid, nw = gridDim.x * 8;
    for (int row = gw; row < T_TOK; row += nw) {
        const f32x4* xr = (const f32x4*)(x + (size_t)row * DMODEL);
        f32x4 v[16]; float ss = 0.f;
#pragma unroll
        for (int i = 0; i < 16; ++i) { v[i] = __builtin_nontemporal_load(xr + i * 64 + lane); ss += v[i][0] * v[i][0] + v[i][1] * v[i][1] + v[i][2] * v[i][2] + v[i][3] * v[i][3]; }
        ss = wave_sum(ss);
        const float rstd = rsqrtf(ss * (1.0f / DMODEL) + 1e-6f);
        bf16_t* orow = xn + (size_t)row * DMODEL;
#pragma unroll
        for (int i = 0; i < 16; ++i) { const f32x4 gg = ((const f32x4*)g)[i * 64 + lane]; u32x2 w; w.x = cvt_pk(v[i][0] * rstd * gg[0], v[i][1] * rstd * gg[1]); w.y = cvt_pk(v[i][2] * rstd * gg[2], v[i][3] * rstd * gg[3]);
            *(u32x2*)(orow + (i * 64 + lane) * 4) = w; }
    }
}
__device__ void phase_transpose(LAS unsigned char* lds, const float* __restrict__ W, int K, int N, int Npad, bf16_t* __restrict__ Wt) {
    const int wid = threadIdx.x >> 6, lane = threadIdx.x & 63;
    const int gw = blockIdx.x * 8 + wid, nw = gridDim.x * 8;
    const int nkt = K / 64, total = nkt * (Npad / 32);
    LAS bf16_t* tl = (LAS bf16_t*)(lds + wid * 4352);
    const int c4 = lane & 7, kr = lane >> 3, rn = lane >> 1, half = lane & 1;
    for (int tile = gw; tile < total; tile += nw) {
        const int nnt = Npad / 32, kt = tile / nnt, nt = tile - kt * nnt, n0 = nt * 32, k0 = kt * 64;
        const int n = n0 + 4 * c4;
#pragma unroll
        for (int it = 0; it < 8; ++it) { const int k = it * 8 + kr;
            f32x4 v = (f32x4){0.f, 0.f, 0.f, 0.f};
            if (n < N) v = __builtin_nontemporal_load((const f32x4*)(W + (size_t)(k0 + k) * N + n));
            const unsigned p0 = cvt_pk(v[0], v[1]), p1 = cvt_pk(v[2], v[3]);
            tl[(4 * c4 + 0) * 66 + k] = (bf16_t)(p0 & 0xffffu); tl[(4 * c4 + 1) * 66 + k] = (bf16_t)(p0 >> 16);
            tl[(4 * c4 + 2) * 66 + k] = (bf16_t)(p1 & 0xffffu); tl[(4 * c4 + 3) * 66 + k] = (bf16_t)(p1 >> 16); }
        asm volatile("s_waitcnt lgkmcnt(0)" ::: "memory");
        __builtin_amdgcn_wave_barrier();
        const LAS unsigned* rp = (const LAS unsigned*)(tl + rn * 66 + 32 * half);
        unsigned d[16];
#pragma unroll
        for (int i = 0; i < 16; ++i) d[i] = rp[i];
        bf16_t* op = Wt + (size_t)(n0 + rn) * K + k0 + 32 * half;
#pragma unroll
        for (int i = 0; i < 4; ++i) *(u32x4*)(op + 8 * i) = (u32x4){d[4 * i], d[4 * i + 1], d[4 * i + 2], d[4 * i + 3]};
        asm volatile("s_waitcnt lgkmcnt(0)" ::: "memory");
        __builtin_amdgcn_wave_barrier();
    }
}

__device__ __forceinline__ void gate_gemm(LAS unsigned char* lds, const bf16_t* __restrict__ xn, const bf16_t* __restrict__ WinT, float* __restrict__ gate, int rb) {
    const int tid = threadIdx.x, wid = tid >> 6, lane = tid & 63, fr = lane & 15, g = lane >> 4;
    f32x4 acc[4][2];
#pragma unroll
    for (int mt = 0; mt < 4; ++mt) { acc[mt][0] = (f32x4){0.f, 0.f, 0.f, 0.f}; acc[mt][1] = (f32x4){0.f, 0.f, 0.f, 0.f}; }
    const bf16_t* arow = xn + (size_t)(rb * 64 + fr) * DMODEL + wid * 512 + 8 * g;
    const bf16_t* brow = WinT + (size_t)(NPROJ + fr) * DMODEL + wid * 512 + 8 * g;
#pragma unroll 4
    for (int ks = 0; ks < 16; ++ks) {
        bf16x8 a[4], b[2];
#pragma unroll
        for (int mt = 0; mt < 4; ++mt) a[mt] = *(const bf16x8*)(arow + (size_t)(16 * mt) * DMODEL + 32 * ks);
#pragma unroll
        for (int nt = 0; nt < 2; ++nt) b[nt] = *(const bf16x8*)(brow + (size_t)(16 * nt) * DMODEL + 32 * ks);
#pragma unroll
        for (int mt = 0; mt < 4; ++mt)
#pragma unroll
            for (int nt = 0; nt < 2; ++nt) acc[mt][nt] = mfma32(a[mt], b[nt], acc[mt][nt]);
    }
    LAS float* red = (LAS float*)lds;
#pragma unroll
    for (int mt = 0; mt < 4; ++mt)
#pragma unroll
        for (int nt = 0; nt < 2; ++nt)
#pragma unroll
            for (int reg = 0; reg < 4; ++reg) red[(wid * 64 + 16 * mt + 4 * g + reg) * 32 + 16 * nt + fr] = acc[mt][nt][reg];
    __syncthreads();
#pragma unroll
    for (int i = 0; i < 4; ++i) { const int e = tid + 512 * i; float s = 0.f;
#pragma unroll
        for (int w = 0; w < 8; ++w) s += red[w * 2048 + e];
        gate[(size_t)(rb * 64) * 32 + e] = s; }
    __syncthreads();
}

constexpr int N_ATTN_TASKS = 3 * 2 * 16 * 64;
#define LDS_BARRIER() do { asm volatile("s_waitcnt lgkmcnt(0)" ::: "memory"); __builtin_amdgcn_s_barrier(); asm volatile("" ::: "memory"); } while (0)
struct AttnPre { u32x4 k[8], v[8]; bf16x8 q[4]; };
struct AttnTask { int p, b, h, n, dil, tb; };
__device__ __forceinline__ AttnTask attn_decode(int task) {
    AttnTask t; t.p = task >> 11; const int rem = task & 2047; t.b = rem >> 10; t.h = (rem >> 6) & 15; const int idx = rem & 63;
    const int dsh = 2 * t.p, nbp = 64 >> dsh; t.dil = 1 << dsh; const int r = idx >> (6 - dsh); t.n = idx & (nbp - 1); t.tb = t.b * SEQ + r; return t;
}
__device__ __forceinline__ void attn_prefetch(AttnPre& P, const bf16_t* __restrict__ proj, int task, bool cont, int tid) {
    const AttnTask t = attn_decode(task);
    const int jb = cont ? 128 : 0;
#pragma unroll
    for (int i = 0; i < 4; ++i) {
        const int c = tid + 512 * i, j = jb + (c >> 4), ch = c & 15, idxk = (t.n - 1) * 128 + j;
        const bf16_t* rowp = proj + (size_t)(t.tb + (idxk < 0 ? 0 : idxk) * t.dil) * NPROJ + t.h * 128 + ch * 8;
        P.k[i] = *(const u32x4*)(rowp + 2048); P.v[i] = *(const u32x4*)(rowp + 4096);
    }
    if (!cont) {
#pragma unroll
        for (int i = 4; i < 8; ++i) {
            const int c = tid + 512 * i, j = c >> 4, ch = c & 15, idxk = (t.n - 1) * 128 + j;
            const bf16_t* rowp = proj + (size_t)(t.tb + (idxk < 0 ? 0 : idxk) * t.dil) * NPROJ + t.h * 128 + ch * 8;
            P.k[i] = *(const u32x4*)(rowp + 2048); P.v[i] = *(const u32x4*)(rowp + 4096);
        }
    }
    { const int wid = tid >> 6, lane = tid & 63, fr = lane & 15, g = lane >> 4;
      const bf16_t* qrow = proj + (size_t)(t.tb + (t.n * 128 + 16 * wid + fr) * t.dil) * NPROJ + t.h * 128;
#pragma unroll
      for (int s = 0; s < 4; ++s) P.q[s] = *(const bf16x8*)(qrow + 32 * s + 8 * g); }
}
__device__ __forceinline__ void attn_compute(LAS unsigned char* lds, const bf16_t* __restrict__ proj, bf16_t* __restrict__ op, float* __restrict__ lsep, int task, int next_task, bool cont, bool next_cont, int par, AttnPre& P) {
    const int tid = threadIdx.x, wid = tid >> 6, lane = tid & 63, fr = lane & 15, g = lane >> 4;
    const AttnTask t = attn_decode(task);
    const int p = t.p, h = t.h, n = t.n, dil = t.dil, px = par << 7;
    const float slope = exp2f(-0.5f * (float)(h + 1));
    { const int jb = cont ? 128 : 0;
#pragma unroll
      for (int i = 0; i < 4; ++i) {
          const int c = tid + 512 * i, j = jb + (c >> 4), ch = c & 15, idxk = (n - 1) * 128 + j, jp = j ^ px;
          u32x4 kv = P.k[i], vv = P.v[i];
          if (idxk < 0) { kv = (u32x4){0u, 0u, 0u, 0u}; vv = (u32x4){0u, 0u, 0u, 0u}; }
          *(LAS u32x4*)(lds + jp * 256 + ((ch ^ (j & 15)) << 4)) = kv;
          *(LAS u32x4*)(lds + 65536 + jp * 256 + ((ch ^ ((j & 7) << 1)) << 4)) = vv;
      }
      if (!cont) {
#pragma unroll
          for (int i = 4; i < 8; ++i) {
              const int c = tid + 512 * i, j = c >> 4, ch = c & 15, idxk = (n - 1) * 128 + j, jp = j ^ px;
              u32x4 kv = P.k[i], vv = P.v[i];
              if (idxk < 0) { kv = (u32x4){0u, 0u, 0u, 0u}; vv = (u32x4){0u, 0u, 0u, 0u}; }
              *(LAS u32x4*)(lds + jp * 256 + ((ch ^ (j & 15)) << 4)) = kv;
              *(LAS u32x4*)(lds + 65536 + jp * 256 + ((ch ^ ((j & 7) << 1)) << 4)) = vv;
          }
      } }
    const int tq = t.tb + (n * 128 + 16 * wid + fr) * dil;
    bf16x8 qf[4];
#pragma unroll
    for (int s = 0; s < 4; ++s) qf[s] = P.q[s];
    LDS_BARRIER();
    if (next_task >= 0) attn_prefetch(P, proj, next_task, next_cont, tid);
    float sc[9][4];
    float mx = -1e30f;
#pragma unroll
    for (int kt9 = 0; kt9 < 9; ++kt9) {
        const int kt = wid + kt9, jr = (16 * kt) ^ px;
        f32x4 acc = (f32x4){0.f, 0.f, 0.f, 0.f};
#pragma unroll
        for (int s = 0; s < 4; ++s) { const bf16x8 kf = *(const LAS bf16x8*)(lds + (jr + fr) * 256 + (((4 * s + g) ^ fr) << 4)); acc = mfma32(kf, qf[s], acc); }
#pragma unroll
        for (int reg = 0; reg < 4; ++reg) { const int j = 16 * kt + 4 * g + reg, l = 16 * wid + fr, dist = l + 128 - j;
            const bool valid = (dist >= 0) && (dist <= 128) && (n > 0 || j >= 128);
            const float v = valid ? acc[reg] * 0.08838834764831845f - slope * (float)(dist * dil) : -1e30f;
            sc[kt9][reg] = v; mx = fmaxf(mx, v); }
    }
    mx = fmaxf(mx, __shfl_xor(mx, 16)); mx = fmaxf(mx, __shfl_xor(mx, 32));
    float sum = 0.f;
    bf16x4 pk[9];
#pragma unroll
    for (int kt9 = 0; kt9 < 9; ++kt9) {
        float e[4];
#pragma unroll
        for (int reg = 0; reg < 4; ++reg) { e[reg] = __expf(sc[kt9][reg] - mx); sum += e[reg]; }
        u32x2 w; w.x = cvt_pk(e[0], e[1]); w.y = cvt_pk(e[2], e[3]);
        pk[kt9] = __builtin_bit_cast(bf16x4, w);
    }
    sum += __shfl_xor(sum, 16); sum += __shfl_xor(sum, 32);
    const float inv = 1.0f / sum, lse = mx + __logf(sum);
    bf16_t* orow = op + ((size_t)p * T_TOK + tq) * 2048 + h * 128;
    const int tq4 = fr >> 2, tp4 = fr & 3, krow = 4 * g + tq4;
    const unsigned vbase = (unsigned)(size_t)lds + 65536u + (unsigned)(krow * 256 + 8 * (tp4 & 1));
    unsigned rt[9];
#pragma unroll
    for (int kt9 = 0; kt9 < 9; ++kt9) rt[kt9] = (unsigned)(((16 * (wid + kt9)) ^ px) * 256);
#pragma unroll
    for (int dt = 0; dt < 8; ++dt) {
        f32x4 acc = (f32x4){0.f, 0.f, 0.f, 0.f};
        const unsigned va = vbase + (unsigned)((((2 * dt + (tp4 >> 1)) ^ ((krow & 7) << 1))) << 4);
        unsigned ad[9];
#pragma unroll
        for (int kt9 = 0; kt9 < 9; ++kt9) ad[kt9] = va + rt[kt9];
        u32x2 vt[9];
        asm volatile("ds_read_b64_tr_b16 %0, %9\n\tds_read_b64_tr_b16 %1, %10\n\tds_read_b64_tr_b16 %2, %11\n\tds_read_b64_tr_b16 %3, %12\n\t"
                     "ds_read_b64_tr_b16 %4, %13\n\tds_read_b64_tr_b16 %5, %14\n\tds_read_b64_tr_b16 %6, %15\n\tds_read_b64_tr_b16 %7, %16\n\t"
                     "ds_read_b64_tr_b16 %8, %17\n\ts_waitcnt lgkmcnt(0)"
                     : "=&v"(vt[0]), "=&v"(vt[1]), "=&v"(vt[2]), "=&v"(vt[3]), "=&v"(vt[4]), "=&v"(vt[5]), "=&v"(vt[6]), "=&v"(vt[7]), "=&v"(vt[8])
                     : "v"(ad[0]), "v"(ad[1]), "v"(ad[2]), "v"(ad[3]), "v"(ad[4]), "v"(ad[5]), "v"(ad[6]), "v"(ad[7]), "v"(ad[8]) : "memory");
#pragma unroll
        for (int kt9 = 0; kt9 < 9; ++kt9) acc = mfma16(__builtin_bit_cast(bf16x4, vt[kt9]), pk[kt9], acc);
        u32x2 w; w.x = cvt_pk(acc[0] * inv, acc[1] * inv); w.y = cvt_pk(acc[2] * inv, acc[3] * inv);
        *(u32x2*)(orow + 16 * dt + 4 * g) = w;
    }
    if (g == 0) lsep[((size_t)p * T_TOK + tq) * 16 + h] = lse;
    LDS_BARRIER();
}
__device__ __forceinline__ void attn_phase(LAS unsigned char* lds, const bf16_t* __restrict__ proj, bf16_t* __restrict__ op, float* __restrict__ lsep, int t0, int t1) {
    const int tid = threadIdx.x;
    if (t0 >= t1) return;
    AttnPre P;
    attn_prefetch(P, proj, t0, false, tid);
    int par = 0; bool cont = false;
    for (int task = t0; task < t1; ++task) {
        const int nxt = task + 1 < t1 ? task + 1 : -1;
        const bool next_cont = nxt >= 0 && attn_decode(nxt).n > 0;
        attn_compute(lds, proj, op, lsep, task, nxt, cont, next_cont, par, P);
        cont = next_cont; par = next_cont ? (par ^ 1) : 0;
    }
    __syncthreads();
}

constexpr int DN_Q = 0, DN_K = 17408, DN_V = 34816, DN_AD = 52224, DN_ABF = 56320, DN_TBF = 65536, DN_GC = 68608, DN_BETA = 68864, DN_EG = 69120, DN_CW = 69376;
__device__ void dn_stage_convw(LAS unsigned char* lds, const float* __restrict__ conv_w, int h) {
    LAS float* cw_s = (LAS float*)(lds + DN_CW);
    for (int e = threadIdx.x; e < 1536; e += 512) { const int j = e / 384, r = e - j * 384, X = r >> 7, col = r & 127; cw_s[e] = conv_w[j * 6144 + X * 2048 + h * 128 + col]; }
    __syncthreads();
}
template <int X> __device__ __forceinline__ void dn_conv_block(LAS unsigned char* lds, const LAS float* cw_s, const u32x4 (&xin)[2][4], int s0, int i, int cg8) {
    float y[16];
#pragma unroll
    for (int hf = 0; hf < 2; ++hf) {
        float acc[8];
#pragma unroll
        for (int e = 0; e < 8; ++e) acc[e] = 0.f;
#pragma unroll
        for (int j = 0; j < 4; ++j) { const int sp = s0 + i - 3 + j; const float mj = sp >= 0 ? 1.0f : 0.0f;
            const u32x4 xv = xin[hf][j];
            const f32x4 w0 = *(const LAS f32x4*)(cw_s + j * 384 + X * 128 + 16 * cg8 + 8 * hf) * mj, w1 = *(const LAS f32x4*)(cw_s + j * 384 + X * 128 + 16 * cg8 + 8 * hf + 4) * mj;
            acc[0] += w0[0] * bflo(xv.x); acc[1] += w0[1] * bfhi(xv.x); acc[2] += w0[2] * bflo(xv.y); acc[3] += w0[3] * bfhi(xv.y);
            acc[4] += w1[0] * bflo(xv.z); acc[5] += w1[1] * bfhi(xv.z); acc[6] += w1[2] * bflo(xv.w); acc[7] += w1[3] * bfhi(xv.w); }
#pragma unroll
        for (int e = 0; e < 8; ++e) y[hf * 8 + e] = silu_f(acc[e]);
        asm volatile("" ::: "memory");
    }
    if (X < 2) { float ss = 0.f;
#pragma unroll
        for (int e = 0; e < 16; ++e) ss += y[e] * y[e];
        ss += __shfl_xor(ss, 1); ss += __shfl_xor(ss, 2); ss += __shfl_xor(ss, 4);
        const float scl = rsqrtf(ss + 1e-6f) * (X == 0 ? 0.08838834764831845f : 1.0f);
#pragma unroll
        for (int e = 0; e < 16; ++e) y[e] *= scl; }
    LAS u32x4* dst = (LAS u32x4*)(lds + X * 17408 + i * 272 + cg8 * 32);
    dst[0] = (u32x4){cvt_pk(y[0], y[1]), cvt_pk(y[2], y[3]), cvt_pk(y[4], y[5]), cvt_pk(y[6], y[7])};
    dst[1] = (u32x4){cvt_pk(y[8], y[9]), cvt_pk(y[10], y[11]), cvt_pk(y[12], y[13]), cvt_pk(y[14], y[15])};
}
struct PrepPre { u32x4 x[2][2][4]; float bl, al, alog, dtb; };
__device__ __forceinline__ void dn_prep_prefetch(PrepPre& P, const bf16_t* __restrict__ proj, const float* __restrict__ gate, const float* __restrict__ a_log, const float* __restrict__ dt_bias, int chunk) {
    const int tid = threadIdx.x, wid = tid >> 6, lane = tid & 63;
    const int bh = chunk >> 7, n = chunk & 127, b = bh >> 4, h = bh & 15, s0 = n * 64, i = tid >> 3, cg8 = tid & 7;
#pragma unroll
    for (int X = 0; X < 2; ++X)
#pragma unroll
        for (int hf = 0; hf < 2; ++hf)
#pragma unroll
            for (int j = 0; j < 4; ++j) { const int sp = s0 + i - 3 + j;
                P.x[X][hf][j] = *(const u32x4*)(proj + ((size_t)b * SEQ + (sp < 0 ? 0 : sp)) * NPROJ + 8192 + X * 2048 + h * 128 + 16 * cg8 + 8 * hf); }
    if (wid == 0) { const size_t t0 = (size_t)b * SEQ + s0; P.bl = gate[(t0 + lane) * 32 + h]; P.al = gate[(t0 + lane) * 32 + 16 + h]; P.alog = a_log[h]; P.dtb = dt_bias[h]; }
}
__device__ __forceinline__ void dn_prep_chunk(LAS unsigned char* lds, const bf16_t* __restrict__ proj, const float* __restrict__ gate, const float* __restrict__ a_log, const float* __restrict__ dt_bias,
                              bf16_t* __restrict__ Wb, bf16_t* __restrict__ Uf, bf16_t* __restrict__ Qd, bf16_t* __restrict__ Kt, bf16_t* __restrict__ Ab, float* __restrict__ Cd, int chunk, int next_chunk, PrepPre& P) {
    int tid_ = threadIdx.x; asm volatile("" : "+v"(tid_));
    const int tid = tid_, wid = tid >> 6, lane = tid & 63, fr = lane & 15, g = lane >> 4;
    const int bh = chunk >> 7, n = chunk & 127, b = bh >> 4, h = bh & 15;
    const int s0 = n * 64;
    LAS float* cw_s = (LAS float*)(lds + DN_CW);
    LAS float* Ad = (LAS float*)(lds + DN_AD); LAS float* gc_s = (LAS float*)(lds + DN_GC); LAS float* beta_s = (LAS float*)(lds + DN_BETA); LAS float* eg_s = (LAS float*)(lds + DN_EG);
    {
        const int i = tid >> 3, cg8 = tid & 7;
        u32x4 xv2[2][4];
#pragma unroll
        for (int hf = 0; hf < 2; ++hf)
#pragma unroll
            for (int j = 0; j < 4; ++j) { const int sp = s0 + i - 3 + j;
                xv2[hf][j] = *(const u32x4*)(proj + ((size_t)b * SEQ + (sp < 0 ? 0 : sp)) * NPROJ + 8192 + 2 * 2048 + h * 128 + 16 * cg8 + 8 * hf); }
        dn_conv_block<0>(lds, cw_s, P.x[0], s0, i, cg8);
        dn_conv_block<1>(lds, cw_s, P.x[1], s0, i, cg8);
        dn_conv_block<2>(lds, cw_s, xv2, s0, i, cg8);
    }
    if (wid == 0) {
        const float beta = 1.0f / (1.0f + expf(-P.bl));
        const float xx = P.al + P.dtb;
        const float sp = xx > 20.f ? xx : log1pf(expf(xx));
        float gc = -expf(P.alog) * sp;
#pragma unroll
        for (int off = 1; off < 64; off <<= 1) { const float v = __shfl_up(gc, off); if (lane >= off) gc += v; }
        gc_s[lane] = gc; beta_s[lane] = beta; eg_s[lane] = expf(gc);
    }
    LDS_BARRIER();
    if (next_chunk >= 0) dn_prep_prefetch(P, proj, gate, a_log, dt_bias, next_chunk);
    {
        const int type = wid >> 2, ti = wid & 3;
        const int i = 16 * ti + fr; const float gi = gc_s[i], bi = beta_s[i];
#pragma unroll
        for (int tj = 0; tj < 4; ++tj) {
            const size_t aoff = (size_t)chunk * 4096 + ((ti * 2 + (tj >> 1)) * 64 + (2 * (tj & 1) + (g >> 1)) * 16 + fr) * 8 + 4 * (g & 1);
            if (tj > ti) { if (type == 1) *(u32x2*)(Ab + aoff) = (u32x2){0u, 0u}; continue; }
            f32x4 acc = (f32x4){0.f, 0.f, 0.f, 0.f};
            const int xoff = type == 0 ? DN_K : DN_Q;
#pragma unroll
            for (int s = 0; s < 4; ++s) { const bf16x8 a = *(const LAS bf16x8*)(lds + DN_K + (16 * tj + fr) * 272 + (32 * s + 8 * g) * 2), bb = *(const LAS bf16x8*)(lds + xoff + i * 272 + (32 * s + 8 * g) * 2); acc = mfma32(a, bb, acc); }
            float v[4];
#pragma unroll
            for (int reg = 0; reg < 4; ++reg) { const int j = 16 * tj + 4 * g + reg; const float e = __expf(fminf(gi - gc_s[j], 0.f));
                v[reg] = type == 0 ? ((i > j) ? -bi * acc[reg] * e : 0.f) : ((i >= j) ? acc[reg] * e : 0.f); }
            if (type == 1) *(u32x2*)(Ab + aoff) = (u32x2){cvt_pk(v[0], v[1]), cvt_pk(v[2], v[3])};
            else if (tj == ti) *(LAS f32x4*)(Ad + (ti * 16 + fr) * 16 + 4 * g) = (f32x4){-v[0], -v[1], -v[2], -v[3]};
            else *(LAS u32x2*)(lds + DN_ABF + i * 144 + (16 * tj + 4 * g) * 2) = (u32x2){cvt_pk(v[0], v[1]), cvt_pk(v[2], v[3])};
        }
    }
    LDS_BARRIER();
    if (wid == 0) {
        const int bb = lane >> 4, c = lane & 15;
        float t[16];
#pragma unroll
        for (int i = 0; i < 16; ++i) {
            float acc = (i == c) ? 1.0f : 0.0f;
#pragma unroll
            for (int jj = 0; jj < (i + 3) / 4; ++jj) { const f32x4 a4 = *(const LAS f32x4*)(Ad + (bb * 16 + i) * 16 + 4 * jj);
#pragma unroll
                for (int e = 0; e < 4; ++e) if (4 * jj + e < i) acc -= a4[e] * t[4 * jj + e]; }
            t[i] = acc;
            *(LAS bf16_t*)(lds + DN_TBF + ((bb * 16 + i) * 24 + c) * 2) = f2bf(acc);
        }
    } else {
        for (int it = tid - 64; it < 512; it += 448) {
            if (it < 256) { const int i = it >> 2, part = it & 3; const float e = eg_s[i];
#pragma unroll
                for (int c4 = 0; c4 < 4; ++c4) { const u32x4 qv = *(const LAS u32x4*)(lds + DN_Q + i * 272 + part * 64 + c4 * 16);
                    u32x4 o; o.x = cvt_pk(bflo(qv.x) * e, bfhi(qv.x) * e); o.y = cvt_pk(bflo(qv.y) * e, bfhi(qv.y) * e); o.z = cvt_pk(bflo(qv.z) * e, bfhi(qv.z) * e); o.w = cvt_pk(bflo(qv.w) * e, bfhi(qv.w) * e);
                    *(u32x4*)(Qd + (size_t)chunk * 8192 + (((i >> 4) * 4 + part) * 64 + c4 * 16 + (i & 15)) * 8) = o; }
            } else { const int t2 = it - 256, d = t2 & 127, ih = t2 >> 7; const float gl = gc_s[63]; const LAS bf16_t* ks = (const LAS bf16_t*)(lds + DN_K) + d;
#pragma unroll
                for (int i8 = 0; i8 < 4; ++i8) { float v[8];
#pragma unroll
                    for (int e = 0; e < 8; ++e) { const int i = 32 * ih + 8 * i8 + e; v[e] = bf2f(ks[i * 136]) * __expf(gl - gc_s[i]); }
                    *(u32x4*)(Kt + (size_t)chunk * 8192 + (((d >> 4) * 2 + ih) * 64 + i8 * 16 + (d & 15)) * 8) = (u32x4){cvt_pk(v[0], v[1]), cvt_pk(v[2], v[3]), cvt_pk(v[4], v[5]), cvt_pk(v[6], v[7])}; } }
        }
        if (tid == 64) Cd[chunk] = expf(gc_s[63]);
    }
    LDS_BARRIER();
#pragma unroll
    for (int cc = 0; cc < 2; ++cc) {
        const int ct = 2 * wid + cc; const bool isu = ct < 8;
        const LAS bf16_t* src = (const LAS bf16_t*)(lds + (isu ? DN_V : DN_K)) + 16 * (ct & 7) + fr;
        bf16x4 Xb[4];
#pragma unroll
        for (int I = 0; I < 4; ++I) {
            f32x4 acc;
#pragma unroll
            for (int reg = 0; reg < 4; ++reg) { const int i = 16 * I + 4 * g + reg; float r = bf2f(src[i * 136]) * beta_s[i]; if (!isu) r *= eg_s[i]; acc[reg] = r; }
#pragma unroll
            for (int J = 0; J < I; ++J) { const bf16x4 a = *(const LAS bf16x4*)(lds + DN_ABF + (16 * I + fr) * 144 + (16 * J + 4 * g) * 2); acc = mfma16(a, Xb[J], acc); }
            const u32x2 yw = (u32x2){cvt_pk(acc[0], acc[1]), cvt_pk(acc[2], acc[3])};
            const bf16x4 tt = *(const LAS bf16x4*)(lds + DN_TBF + ((I * 16 + fr) * 24 + 4 * g) * 2);
            const f32x4 x = mfma16(tt, __builtin_bit_cast(bf16x4, yw), (f32x4){0.f, 0.f, 0.f, 0.f});
            const u32x2 xw = (u32x2){cvt_pk(x[0], x[1]), cvt_pk(x[2], x[3])};
            Xb[I] = __builtin_bit_cast(bf16x4, xw);
            if (isu) *(u32x2*)(Uf + ((((size_t)chunk * 8 + ct) * 4 + I) * 64 + lane) * 4) = xw;
            else {
#pragma unroll
                for (int reg = 0; reg < 4; ++reg) Wb[(size_t)chunk * 8192 + ((I * 4 + ((16 * (ct - 8) + fr) >> 5)) * 64 + (((16 * (ct - 8) + fr) >> 3) & 3) * 16 + 4 * g + reg) * 8 + (fr & 7)] = (bf16_t)(reg & 1 ? (reg & 2 ? xw.y >> 16 : xw.x >> 16) : (reg & 2 ? xw.y & 0xffffu : xw.x & 0xffffu));
            }
        }
    }
    LDS_BARRIER();
}

struct ScanRegs { bf16x8 f1[4], af[2], kf[2]; u32x2 uv; float cd; };
__device__ __forceinline__ void scan_load(ScanRegs& R, const bf16_t* __restrict__ Wb, const bf16_t* __restrict__ Uf, const bf16_t* __restrict__ Qd, const bf16_t* __restrict__ Kt, const bf16_t* __restrict__ Ab, const float* __restrict__ Cd,
                                          int chunk, int wid, int lane, int fr, int g, int sl) {
    const int tt = wid & 3;
    const bf16_t* src = (wid < 4 ? Wb : Qd) + (size_t)chunk * 8192 + (tt * 4 * 64 + lane) * 8;
#pragma unroll
    for (int s = 0; s < 4; ++s) R.f1[s] = *(const bf16x8*)(src + s * 512);
    R.uv = *(const u32x2*)(Uf + ((((size_t)chunk * 8 + sl) * 4 + tt) * 64 + lane) * 4);
#pragma unroll
    for (int s = 0; s < 2; ++s) R.af[s] = *(const bf16x8*)(Ab + (size_t)chunk * 4096 + ((tt * 2 + s) * 64 + lane) * 8);
#pragma unroll
    for (int s = 0; s < 2; ++s) R.kf[s] = *(const bf16x8*)(Kt + (size_t)chunk * 8192 + ((wid * 2 + s) * 64 + lane) * 8);
    R.cd = Cd[chunk];
}
__device__ __forceinline__ void scan_step(LAS unsigned char* lds, const ScanRegs& R, f32x4& Sacc, bf16_t* __restrict__ orow, size_t ostride, int wid, int fr, int g) {
    f32x4 acc = (f32x4){0.f, 0.f, 0.f, 0.f};
#pragma unroll
    for (int s = 0; s < 4; ++s) { const bf16x8 sf = *(const LAS bf16x8*)(lds + fr * 272 + (32 * s + 8 * g) * 2); acc = mfma32(R.f1[s], sf, acc); }
    const int voff = wid < 4 ? 4352 + fr * 144 + (16 * wid + 4 * g) * 2 : 8192 + (wid * 64 + g * 16 + fr) * 8;
    *(LAS u32x2*)(lds + voff) = (u32x2){cvt_pk(bflo(R.uv.x) - acc[0], bfhi(R.uv.x) - acc[1]), cvt_pk(bflo(R.uv.y) - acc[2], bfhi(R.uv.y) - acc[3])};
    LDS_BARRIER();
    const bf16x8 v0 = *(const LAS bf16x8*)(lds + 4352 + fr * 144 + (8 * g) * 2), v1 = *(const LAS bf16x8*)(lds + 4352 + fr * 144 + (32 + 8 * g) * 2);
    Sacc = Sacc * R.cd;
    Sacc = mfma32(R.kf[0], v0, Sacc); Sacc = mfma32(R.kf[1], v1, Sacc);
    *(LAS u32x2*)(lds + fr * 272 + (16 * wid + 4 * g) * 2) = (u32x2){cvt_pk(Sacc[0], Sacc[1]), cvt_pk(Sacc[2], Sacc[3])};
    acc = mfma32(R.af[0], v0, acc); acc = mfma32(R.af[1], v1, acc);
#pragma unroll
    for (int reg = 0; reg < 4; ++reg) orow[(size_t)reg * ostride] = f2bf(acc[reg]);
    LDS_BARRIER();
}
__device__ void dn_scan_item(LAS unsigned char* lds, const bf16_t* __restrict__ Wb, const bf16_t* __restrict__ Uf, const bf16_t* __restrict__ Qd, const bf16_t* __restrict__ Kt, const bf16_t* __restrict__ Ab, const float* __restrict__ Cd,
                             bf16_t* __restrict__ Odn, bf16_t* __restrict__ dump, int item) {
    const int tid = threadIdx.x, wid = __builtin_amdgcn_readfirstlane(tid >> 6), lane = tid & 63, fr = lane & 15, g = lane >> 4;
    const int bh = (item & 7) + 8 * (item >> 6), sl = (item >> 3) & 7, b = bh >> 4, h = bh & 15;
    f32x4 Sacc = (f32x4){0.f, 0.f, 0.f, 0.f};
    *(LAS u32x2*)(lds + fr * 272 + (16 * wid + 4 * g) * 2) = (u32x2){0u, 0u};
    __syncthreads();
    const int c0 = bh * 128;
    bf16_t* obase = wid >= 4 ? Odn + ((size_t)b * SEQ + 16 * (wid - 4) + 4 * g) * 2048 + h * 128 + 16 * sl + fr : dump + ((size_t)blockIdx.x * 512 + tid) * 4;
    const size_t ostride = wid >= 4 ? 2048 : 1, ostep = wid >= 4 ? (size_t)64 * 2048 : 0;
    ScanRegs R0, R1, R2, R3, R4;
#define SLOAD(R, n) scan_load(R, Wb, Uf, Qd, Kt, Ab, Cd, c0 + (n), wid, lane, fr, g, sl)
#define SSTEP(RC, RP, n) if ((n) < 128) { if ((n) + 4 < 128) SLOAD(RP, (n) + 4); scan_step(lds, RC, Sacc, obase + (size_t)(n) * ostep, ostride, wid, fr, g); }
    SLOAD(R0, 0); SLOAD(R1, 1); SLOAD(R2, 2); SLOAD(R3, 3);
    for (int n = 0; n < 128; n += 5) {
        SSTEP(R0, R4, n) SSTEP(R1, R0, n + 1) SSTEP(R2, R1, n + 2) SSTEP(R3, R2, n + 3) SSTEP(R4, R3, n + 4)
    }
#undef SLOAD
#undef SSTEP
    __syncthreads();
}

__device__ void phase_finalize(const bf16_t* __restrict__ proj, const bf16_t* __restrict__ op, const float* __restrict__ lsep, const bf16_t* __restrict__ Odn, const float* __restrict__ dn_g, bf16_t* __restrict__ mixed) {
    const int tid = threadIdx.x, sub = tid & 15;
    f32x4 g0 = *(const f32x4*)(dn_g + sub * 8), g1 = *(const f32x4*)(dn_g + sub * 8 + 4);
    for (int base = blockIdx.x * 32; base < T_TOK * 16; base += gridDim.x * 32) {
        const int pi = base + (tid >> 4), t = pi >> 4, h = pi & 15;
        { const float l0 = lsep[((size_t)0 * T_TOK + t) * 16 + h], l1 = lsep[((size_t)1 * T_TOK + t) * 16 + h], l2 = lsep[((size_t)2 * T_TOK + t) * 16 + h];
          const float m = fmaxf(l0, fmaxf(l1, l2)); float e0 = __expf(l0 - m), e1 = __expf(l1 - m), e2 = __expf(l2 - m); const float inv = 1.0f / (e0 + e1 + e2); e0 *= inv; e1 *= inv; e2 *= inv;
          const size_t oo = (size_t)t * 2048 + h * 128 + sub * 8;
          const u32x4 a0 = __builtin_nontemporal_load((const u32x4*)(op + oo)), a1 = __builtin_nontemporal_load((const u32x4*)(op + (size_t)T_TOK * 2048 + oo)), a2 = __builtin_nontemporal_load((const u32x4*)(op + (size_t)2 * T_TOK * 2048 + oo));
          const u32x4 gt = __builtin_nontemporal_load((const u32x4*)(proj + (size_t)t * NPROJ + 6144 + h * 128 + sub * 8));
          u32x4 o;
#define MIXW(F) { const float lo = (e0 * bflo(a0.F) + e1 * bflo(a1.F) + e2 * bflo(a2.F)) * silu_f(bflo(gt.F)), hi = (e0 * bfhi(a0.F) + e1 * bfhi(a1.F) + e2 * bfhi(a2.F)) * silu_f(bfhi(gt.F)); o.F = cvt_pk(lo, hi); }
          MIXW(x) MIXW(y) MIXW(z) MIXW(w)
#undef MIXW
          *(u32x4*)(mixed + (size_t)t * DMODEL + h * 128 + sub * 8) = o; }
        { const u32x4 ov = __builtin_nontemporal_load((const u32x4*)(Odn + (size_t)t * 2048 + h * 128 + sub * 8));
          float v[8] = {bflo(ov.x), bfhi(ov.x), bflo(ov.y), bfhi(ov.y), bflo(ov.z), bfhi(ov.z), bflo(ov.w), bfhi(ov.w)};
          float ss = 0.f;
#pragma unroll
          for (int e = 0; e < 8; ++e) ss += v[e] * v[e];
          ss += __shfl_xor(ss, 1); ss += __shfl_xor(ss, 2); ss += __shfl_xor(ss, 4); ss += __shfl_xor(ss, 8);
          const float rstd = rsqrtf(ss * (1.0f / 128.0f) + 1e-6f);
          const u32x4 gt = __builtin_nontemporal_load((const u32x4*)(proj + (size_t)t * NPROJ + 14336 + h * 128 + sub * 8));
          u32x4 o;
          o.x = cvt_pk(v[0] * rstd * g0[0] * silu_f(bflo(gt.x)), v[1] * rstd * g0[1] * silu_f(bfhi(gt.x)));
          o.y = cvt_pk(v[2] * rstd * g0[2] * silu_f(bflo(gt.y)), v[3] * rstd * g0[3] * silu_f(bfhi(gt.y)));
          o.z = cvt_pk(v[4] * rstd * g1[0] * silu_f(bflo(gt.z)), v[5] * rstd * g1[1] * silu_f(bfhi(gt.z)));
          o.w = cvt_pk(v[6] * rstd * g1[2] * silu_f(bflo(gt.w)), v[7] * rstd * g1[3] * silu_f(bfhi(gt.w)));
          *(u32x4*)(mixed + (size_t)t * DMODEL + 2048 + h * 128 + sub * 8) = o; }
    }
}

__device__ void phase_final_norm(const bf16_t* __restrict__ H, float* __restrict__ out, const float* __restrict__ g) {
    const int wid = threadIdx.x >> 6, lane = threadIdx.x & 63;
    const int gw = blockIdx.x * 8 + wid, nw = gridDim.x * 8;
    for (int row = gw; row < T_TOK; row += nw) {
        const u32x4* hr = (const u32x4*)(H + (size_t)row * DMODEL);
        f32x4* orow = (f32x4*)(out + (size_t)row * DMODEL);
        u32x4 v[8]; float ss = 0.f;
#pragma unroll
        for (int i = 0; i < 8; ++i) { v[i] = __builtin_nontemporal_load(hr + i * 64 + lane);
            ss += bflo(v[i].x) * bflo(v[i].x) + bfhi(v[i].x) * bfhi(v[i].x) + bflo(v[i].y) * bflo(v[i].y) + bfhi(v[i].y) * bfhi(v[i].y)
                + bflo(v[i].z) * bflo(v[i].z) + bfhi(v[i].z) * bfhi(v[i].z) + bflo(v[i].w) * bflo(v[i].w) + bfhi(v[i].w) * bfhi(v[i].w); }
        ss = wave_sum(ss);
        const float rstd = rsqrtf(ss * (1.0f / DMODEL) + 1e-6f);
#pragma unroll
        for (int i = 0; i < 8; ++i) { const int e = (i * 64 + lane) * 2; const f32x4 g0 = ((const f32x4*)g)[e], g1 = ((const f32x4*)g)[e + 1];
            __builtin_nontemporal_store((f32x4){bflo(v[i].x), bfhi(v[i].x), bflo(v[i].y), bfhi(v[i].y)} * rstd * g0, orow + e);
            __builtin_nontemporal_store((f32x4){bflo(v[i].z), bfhi(v[i].z), bflo(v[i].w), bfhi(v[i].w)} * rstd * g1, orow + e + 1); }
    }
}

__global__ void __launch_bounds__(512, 2) mega_fwd(Params p) {
    extern __shared__ __attribute__((aligned(16))) unsigned char shm[];
    LAS unsigned char* lds = (LAS unsigned char*)shm;
    cg::grid_group grid = cg::this_grid();
    unsigned char* ws = p.ws;
    bf16_t* xn = (bf16_t*)(ws + OFF_XN); bf16_t* WinT = (bf16_t*)(ws + OFF_WINT); bf16_t* WoutT = (bf16_t*)(ws + OFF_WOUTT); bf16_t* proj = (bf16_t*)(ws + OFF_PROJ);
    float* gate = (float*)(ws + OFF_GATE); bf16_t* mixed = (bf16_t*)(ws + OFF_MIXED); bf16_t* Ab = (bf16_t*)(ws + OFF_AB); float* lsep = (float*)(ws + OFF_LSE); float* Cd = (float*)(ws + OFF_CD);
    bf16_t* Wb = (bf16_t*)(ws + OFF_WB); bf16_t* Ub = (bf16_t*)(ws + OFF_UB); bf16_t* Qd = (bf16_t*)(ws + OFF_QD); bf16_t* Kt = (bf16_t*)(ws + OFF_KT);
    bf16_t* op = (bf16_t*)((unsigned char*)p.out + OUT_OP); bf16_t* Odn = (bf16_t*)((unsigned char*)p.out + OUT_ODN);
    const int G = (int)gridDim.x, c = (int)blockIdx.x;
    volatile LAS unsigned* xst = (volatile LAS unsigned*)(lds + 131072);
    if (threadIdx.x == 0) { xst[0] = 0u; xst[1] = 0u; }
    __syncthreads();
    XcdBarrier xb = xcd_barrier_post((unsigned*)(ws + WS_BAR), xst);

    if (p.mask & 1) for (int rep = 0; rep < REP_P0; ++rep) {
        phase_transpose(lds, p.w_out, DMODEL, DMODEL, DMODEL, WoutT);
        phase_transpose(lds, p.w_in, DMODEL, NIN, NIN, WinT);
        phase_rmsnorm_x(p.x, p.norm_g, xn);
    }
    if (p.coop == 2) grid.sync();
    if (p.coop) xcd_barrier(xb);
    if (p.mask & 2) {
        __syncthreads();
        for (int rb = c; rb < T_TOK / 64; rb += G) gate_gemm(lds, xn, WinT, gate, rb);
        pg8::Gemm g{xn, WinT, T_TOK, NPROJ, DMODEL}; RepOrder S; S.init(T_TOK, NPROJ, G, c); S.reps = REP_G1; EpiProj E{proj, gate};
        pg8::gemm_phase<EpiProj, RepOrder, false>(lds, g, S, E, nullptr);
        __syncthreads();
    }
    if (p.coop) xcd_barrier(xb);
    if (p.mask & 4) {
        { const int per = (N_ATTN_TASKS + G - 1) / G; for (int rep = 0; rep < REP_ATT; ++rep) attn_phase(lds, proj, op, lsep, c * per, (c + 1) * per < N_ATTN_TASKS ? (c + 1) * per : N_ATTN_TASKS); }
        for (int rep = 0; rep < REP_PREP; ++rep) { const int per = (4096 + G - 1) / G; int hprev = -1;
            const int ch0 = c * per, ch1 = (c + 1) * per < 4096 ? (c + 1) * per : 4096;
            PrepPre P;
            if (ch0 < ch1) dn_prep_prefetch(P, proj, gate, p.a_log, p.dt_bias, ch0);
            for (int chunk = ch0; chunk < ch1; ++chunk) { const int hh = (chunk >> 7) & 15;
                if (hh != hprev) { dn_stage_convw(lds, p.conv_w, hh); hprev = hh; }
                dn_prep_chunk(lds, proj, gate, p.a_log, p.dt_bias, Wb, Ub, Qd, Kt, Ab, Cd, chunk, chunk + 1 < ch1 ? chunk + 1 : -1, P); }
            __syncthreads(); }
    }
    if (p.coop) xcd_barrier(xb);
    if (p.mask & 8) {
        for (int rep = 0; rep < REP_SCAN; ++rep) for (int item = c; item < 256; item += G) dn_scan_item(lds, Wb, Ub, Qd, Kt, Ab, Cd, Odn, (bf16_t*)(ws + WS_END), item);
    }
    if (p.coop) xcd_barrier(xb);
    if (p.mask & 16) for (int rep = 0; rep < REP_FIN; ++rep) phase_finalize(proj, op, lsep, Odn, p.dn_norm_g, mixed);
    if (p.coop) xcd_barrier(xb);
    if (p.mask & 32) {
        __syncthreads();
        pg8::Gemm g{mixed, WoutT, T_TOK, DMODEL, DMODEL}; pg8::StaticOrder S; S.init(T_TOK, DMODEL, G, c); EpiResidBf E{proj  , p.x};
        pg8::gemm_phase<EpiResidBf, pg8::StaticOrder, false>(lds, g, S, E, nullptr);
        __syncthreads();
    }
    if (p.coop) xcd_barrier(xb);
    if (p.mask & 64) phase_final_norm(proj, p.out, p.final_g);
}

extern "C" void kernel_launch(void* const* d_in, const int* in_sizes, int n_in, void* d_out, int out_size, void* d_ws, size_t ws_size, hipStream_t stream) {
    static int grid = 0;
    if (grid == 0) {
        if (n_in != 9 || out_size != T_TOK * DMODEL || ws_size < WS_BAR + XCD_BAR_WORDS * 4) { fprintf(stderr, "kernel_launch: unexpected shapes (n_in %d out %d ws %zu)\n", n_in, out_size, ws_size); grid = -1; return; }
        int dev = 0, cus = 0, per_cu = 0;
        hipGetDevice(&dev); hipDeviceGetAttribute(&cus, hipDeviceAttributeMultiprocessorCount, dev);
        if (hipFuncSetAttribute((const void*)mega_fwd, hipFuncAttributeMaxDynamicSharedMemorySize, LDS_BYTES) != hipSuccess) { fprintf(stderr, "kernel_launch: hipFuncSetAttribute failed\n"); grid = -1; return; }
        if (hipOccupancyMaxActiveBlocksPerMultiprocessor(&per_cu, (const void*)mega_fwd, 512, LDS_BYTES) != hipSuccess || per_cu < 1) { fprintf(stderr, "kernel_launch: occupancy query gives %d\n", per_cu); per_cu = 1; }
        (void)hipGetLastError();
        grid = cus * 1;
    }
    if (grid < 0) return;
    if (hipMemsetAsync((char*)d_ws + WS_BAR, 0, XCD_BAR_WORDS * 4, stream) != hipSuccess) { fprintf(stderr, "kernel_launch: memset of barrier words failed\n"); return; }
    Params p{};
    p.x = (const float*)d_in[0]; p.norm_g = (const float*)d_in[1]; p.w_in = (const float*)d_in[2]; p.conv_w = (const float*)d_in[3]; p.a_log = (const float*)d_in[4];
    p.dt_bias = (const float*)d_in[5]; p.dn_norm_g = (const float*)d_in[6]; p.w_out = (const float*)d_in[7]; p.final_g = (const float*)d_in[8];
    p.out = (float*)d_out; p.ws = (unsigned char*)d_ws;
#if MK_COOP
    p.mask = 127; p.coop = 1;
    void* args[] = {&p};
    hipError_t e = hipLaunchCooperativeKernel((const void*)mega_fwd, dim3(grid), dim3(512), args, LDS_BYTES, stream);
    if (e != hipSuccess) fprintf(stderr, "cooperative launch failed: %s (grid %d)\n", hipGetErrorString(e), grid);
#else
    p.coop = 0;
    for (int ph = 0; ph < 7; ++ph) { p.mask = 1 << ph; hipLaunchKernelGGL(mega_fwd, dim3(grid), dim3(512), LDS_BYTES, stream, p); }
#endif
}
```

```cpp
#include <hip/hip_runtime.h>
#include <hip/hip_cooperative_groups.h>
#include <cstdio>
namespace cg = cooperative_groups;

#ifndef MK_COOP
#define MK_COOP 1
#endif

#ifndef REP_P0
#define REP_P0 1
#endif
#ifndef REP_G1
#define REP_G1 1
#endif
#ifndef REP_ATT
#define REP_ATT 1
#endif
#ifndef REP_PREP
#define REP_PREP 1
#endif
#ifndef REP_SCAN
#define REP_SCAN 1
#endif
#ifndef REP_FIN
#define REP_FIN 1
#endif
namespace pg8 {
#define PG8_LAS __attribute__((address_space(3)))
typedef unsigned short bf16_t;
typedef short bf16x8 __attribute__((ext_vector_type(8)));
typedef float f32x4 __attribute__((ext_vector_type(4)));
typedef unsigned u32x4 __attribute__((ext_vector_type(4)));
constexpr int BM = 256, BK = 64, HALF = 128, HTB = HALF * BK * 2  , STAGE_BYTES = 8 * HTB, NXCD = 8, WGM = 8;

__host__ __device__ __forceinline__ int lds_byte(int r, int c) { const int st = (r >> 4) * 2 + (c >> 5), rr = r & 15, cc = c & 31, ob = rr * 64 + cc * 2; return st * 1024 + (ob ^ (((ob >> 9) & 1) << 5)); }
__host__ __device__ __forceinline__ void stage_rc(int b, int& R, int& C) { const int st = b / 1024, sb = b % 1024, swz = sb ^ (((sb >> 9) & 1) << 5); R = (st >> 1) * 16 + swz / 64; C = (st & 1) * 32 + (swz % 64) / 2; }
__host__ __device__ __forceinline__ int perm32(int rho) { const int n = rho >> 4, i = rho & 15; return 8 * (i >> 2) + 4 * n + (i & 3); }

struct Unit { int pm, pn; };
struct Gemm { const bf16_t* A; const bf16_t* Bt; int M, N, K; };

struct StaticOrder {
    int nM, nN, nwg, G, c;
    __host__ __device__ void init(int M, int N, int G_, int c_) { nM = M / BM; nN = N / BM; nwg = nM * nN; G = G_; c = c_; }
    __host__ __device__ bool next(int i, Unit& u) const {
        const long L = (long)i * G + c; if (L >= nwg) return false;
        int wgid = (int)L; { const int q = nwg / NXCD, r = nwg % NXCD, xcd = wgid % NXCD, off = wgid / NXCD; wgid = (xcd < r ? xcd * (q + 1) : r * (q + 1) + (xcd - r) * q) + off; }
        const int nig = WGM * nN, gid = wgid / nig, fm = gid * WGM, gsz = (nM - fm) < WGM ? (nM - fm) : WGM;
        u.pm = fm + ((wgid % nig) % gsz); u.pn = (wgid % nig) / gsz; return true;
    }
    __device__ __forceinline__ void a_ready(const Unit&) const {}
    __device__ __forceinline__ void done(const Unit&) const {}
};
template <class Epi, class Sched, bool STAMP = false>
__device__ __forceinline__ void gemm_phase(PG8_LAS unsigned char* lds, const Gemm g, const Sched& S, const Epi& E, unsigned long long* stamps) {
    const int tid = threadIdx.x, wid = __builtin_amdgcn_readfirstlane(tid >> 6), lane = tid & 63, wr = wid >> 2, wc = wid & 3, fr = lane & 15, fq = lane >> 4;
    const int K = g.K, nt = K / BK;
    int ts_lo = 0, ts_hi = 0, nts = 0; const unsigned long long rt_entry = STAMP ? (unsigned long long)wall_clock64() : 0ull;
#define PG8_STAMP() do { if (STAMP && wid == 0 && nts < 64) { const unsigned long long _c = (unsigned long long)clock64(); \
        ts_lo = (lane == nts) ? (int)(unsigned)_c : ts_lo; ts_hi = (lane == nts) ? (int)(unsigned)(_c >> 32) : ts_hi; ++nts; } } while (0)
    PG8_STAMP();
    unsigned voffA[2], voffB[2];
#pragma unroll
    for (int i = 0; i < 2; ++i) { int R, C; stage_rc(tid * 16 + i * 8192, R, C); const int Rb = Epi::PERM ? ((R & ~31) + perm32(R & 31)) : R;
        voffA[i] = (unsigned)(R * K + C) * 2u; voffB[i] = (unsigned)(Rb * K + C) * 2u; }
    const size_t kstep = (size_t)(BK * 2);
    const size_t hstep = (size_t)HALF * K * 2;
    const size_t tstep = 2 * hstep;
    const unsigned ldsw = (unsigned)wid * 1024u;
    const int aoff = lds_byte(wr * 64 + fr, fq * 8), boff = lds_byte(wc * 32 + fr, fq * 8);
#define PG8_SA(b, h) (((b) * 2 + (h)) * HTB)
#define PG8_SB(b, h) ((4 + (b) * 2 + (h)) * HTB)
#define PG8_STAGE(bufoff, gbase, voff) do { _Pragma("unroll") for (int _i = 0; _i < 2; ++_i) \
        __builtin_amdgcn_global_load_lds((const unsigned*)((const char*)(gbase) + (voff)[_i]), (PG8_LAS unsigned*)(lds + (bufoff) + ldsw + _i * 8192), 16, 0, 0); } while (0)
#define PG8_LDA(dst, b, h) do { _Pragma("unroll") for (int m = 0; m < 4; ++m) _Pragma("unroll") for (int k = 0; k < 2; ++k) dst[m][k] = *(const PG8_LAS bf16x8*)(lds + PG8_SA(b, h) + aoff + m * 2048 + k * 1024); } while (0)
#define PG8_LDB(dst, b, h) do { _Pragma("unroll") for (int n = 0; n < 2; ++n) _Pragma("unroll") for (int k = 0; k < 2; ++k) dst[n][k] = *(const PG8_LAS bf16x8*)(lds + PG8_SB(b, h) + boff + n * 2048 + k * 1024); } while (0)
#define PG8_MMA(ai, bj, At, Bt) do { __builtin_amdgcn_s_setprio(1); _Pragma("unroll") for (int m = 0; m < 4; ++m) _Pragma("unroll") for (int n = 0; n < 2; ++n) _Pragma("unroll") for (int k = 0; k < 2; ++k) \
        acc[ai][bj][m][n] = __builtin_amdgcn_mfma_f32_16x16x32_bf16(Bt[n][k], At[m][k], acc[ai][bj][m][n], 0, 0, 0); __builtin_amdgcn_s_setprio(0); } while (0)
#define PG8_WAIT_V(n) asm volatile("s_waitcnt vmcnt(" #n ")" ::: "memory")
#define PG8_WAIT_L(n) asm volatile("s_waitcnt lgkmcnt(" #n ")" ::: "memory")
#define PG8_BAR __builtin_amdgcn_s_barrier()
#define PG8_SCHED __builtin_amdgcn_sched_barrier(0)
    Unit cur, nxt; int ui = 0;
    if (!S.next(0, cur)) return;
    f32x4 acc[2][2][4][2];
#pragma unroll
    for (int a = 0; a < 2; ++a)
#pragma unroll
        for (int b = 0; b < 2; ++b)
#pragma unroll
            for (int m = 0; m < 4; ++m)
#pragma unroll
                for (int n = 0; n < 2; ++n) acc[a][b][m][n] = (f32x4){0.f, 0.f, 0.f, 0.f};
    bf16x8 At[4][2], B0[2][2], B1[2][2];
    const char* cA = (const char*)g.A + (size_t)cur.pm * tstep; const char* cB = (const char*)g.Bt + (size_t)cur.pn * tstep;
    S.a_ready(cur);
    PG8_STAGE(PG8_SB(0, 0), cB, voffB); PG8_STAGE(PG8_SA(0, 0), cA, voffA); PG8_STAGE(PG8_SB(0, 1), cB + hstep, voffB); PG8_STAGE(PG8_SA(0, 1), cA + hstep, voffA);
    if (wr == 1) PG8_BAR;
    PG8_WAIT_V(4); PG8_BAR;
    PG8_STAGE(PG8_SB(1, 0), cB + kstep, voffB); PG8_STAGE(PG8_SA(1, 0), cA + kstep, voffA); PG8_STAGE(PG8_SB(1, 1), cB + hstep + kstep, voffB);
    PG8_WAIT_V(6); PG8_BAR;
    PG8_STAMP();
    for (;;) {
        const bool has_next = S.next(ui + 1, nxt);
        const char* nA = has_next ? (const char*)g.A + (size_t)nxt.pm * tstep : cA; const char* nB = has_next ? (const char*)g.Bt + (size_t)nxt.pn * tstep : cB;
        for (int t = 0; t < nt; t += 2) {
            const bool last = (t == nt - 2);
            const char* a1 = cA + (size_t)(t + 1) * kstep;
            const char* a2 = last ? nA : cA + (size_t)(t + 2) * kstep; const char* b2 = last ? nB : cB + (size_t)(t + 2) * kstep;
            const char* a3 = a2 + kstep; const char* b3 = b2 + kstep;
            if (last && has_next) S.a_ready(nxt);
            PG8_LDB(B0, 0, 0); PG8_SCHED; PG8_LDA(At, 0, 0); PG8_STAGE(PG8_SA(1, 1), a1 + hstep, voffA);
            PG8_WAIT_L(8); PG8_BAR; PG8_WAIT_L(0); PG8_MMA(0, 0, At, B0); PG8_BAR; PG8_SCHED;
            PG8_LDB(B1, 0, 1); PG8_STAGE(PG8_SB(0, 0), b2, voffB);
            PG8_BAR; PG8_WAIT_L(0); PG8_MMA(0, 1, At, B1); PG8_BAR;
            PG8_LDA(At, 0, 1); PG8_STAGE(PG8_SA(0, 0), a2, voffA);
            PG8_BAR; PG8_WAIT_L(0); PG8_MMA(1, 0, At, B0); PG8_BAR; PG8_SCHED;
            PG8_STAGE(PG8_SB(0, 1), b2 + hstep, voffB);
            PG8_WAIT_V(6); PG8_BAR; PG8_MMA(1, 1, At, B1); PG8_BAR;
            PG8_LDB(B0, 1, 0); PG8_SCHED; PG8_LDA(At, 1, 0); PG8_STAGE(PG8_SA(0, 1), a2 + hstep, voffA);
            PG8_WAIT_L(8); PG8_BAR; PG8_WAIT_L(0); PG8_MMA(0, 0, At, B0); PG8_BAR; PG8_SCHED;
            PG8_LDB(B1, 1, 1); PG8_STAGE(PG8_SB(1, 0), b3, voffB);
            PG8_BAR; PG8_WAIT_L(0); PG8_MMA(0, 1, At, B1); PG8_BAR;
            PG8_LDA(At, 1, 1); PG8_STAGE(PG8_SA(1, 0), a3, voffA);
            PG8_BAR; PG8_WAIT_L(0); PG8_MMA(1, 0, At, B0); PG8_BAR; PG8_SCHED;
            PG8_STAGE(PG8_SB(1, 1), b3 + hstep, voffB);
            PG8_WAIT_V(6); PG8_BAR; PG8_MMA(1, 1, At, B1); PG8_BAR;
        }
        PG8_STAMP();
        if constexpr (!Epi::AFTER_DRAIN) { E(acc, cur, wr, wc, fr, fq); S.done(cur); }
        PG8_STAMP();
        if (!has_next) break;
#pragma unroll
        for (int a = 0; a < 2; ++a)
#pragma unroll
            for (int b = 0; b < 2; ++b)
#pragma unroll
                for (int m = 0; m < 4; ++m)
#pragma unroll
                    for (int n = 0; n < 2; ++n) acc[a][b][m][n] = (f32x4){0.f, 0.f, 0.f, 0.f};
        cur = nxt; cA = nA; cB = nB; ++ui;
    }
    PG8_WAIT_V(0);
    if (wr == 0) PG8_BAR;
    PG8_BAR;
    if constexpr (Epi::AFTER_DRAIN) { E.fused(acc, cur, wr, wc, fr, fq, lds, wid, lane); S.done(cur); }
    PG8_STAMP();
    if (STAMP && wid == 0) { stamps[lane] = lane < nts ? (((unsigned long long)(unsigned)ts_hi << 32) | (unsigned)ts_lo) : 0ull;
        if (lane == 62) stamps[62] = rt_entry; if (lane == 63) stamps[63] = (unsigned long long)wall_clock64(); }
#undef PG8_STAMP
#undef PG8_SA
#undef PG8_SB
#undef PG8_STAGE
#undef PG8_LDA
#undef PG8_LDB
#undef PG8_MMA
#undef PG8_WAIT_V
#undef PG8_WAIT_L
#undef PG8_BAR
#undef PG8_SCHED
}
}

#define LAS __attribute__((address_space(3)))
#define XB_TMO      128
#define XB_XCNT(j)  (256  + 64 * (j))
#define XB_XSUB(j)  (1280 + 64 * (j))
#define XB_XGEN(j)  (2304 + 64 * (j))
#define XB_TOP      3328
#define XB_TOPGEN   3392
#define XCD_BAR_WORDS 3456
#define XB_SPIN_CAP (1u << 18)

__device__ __forceinline__ unsigned xb_ld(unsigned* p)              { return __hip_atomic_load(p, __ATOMIC_RELAXED, __HIP_MEMORY_SCOPE_AGENT); }
__device__ __forceinline__ unsigned xb_add(unsigned* p, unsigned v) { return __hip_atomic_fetch_add(p, v, __ATOMIC_RELAXED, __HIP_MEMORY_SCOPE_AGENT); }
__device__ __forceinline__ unsigned xb_xcc_id() { return (unsigned)__builtin_amdgcn_s_getreg((3 << 11) | 20) & 0xFu; }
#define XB_SPIN(cond, bar) do { unsigned _sp = 0; while (cond) { __builtin_amdgcn_s_sleep(1); \
    if ((++_sp & 255u) == 0u) { if (xb_ld(&(bar)[XB_TMO])) break; if (_sp > XB_SPIN_CAP) { atomicAdd(&(bar)[XB_TMO], 1u); break; } } } } while (0)

struct XcdBarrier {
    unsigned* bar; unsigned x;
    volatile LAS unsigned* st;
};

__device__ __forceinline__ XcdBarrier xcd_barrier_post(unsigned* bar, volatile LAS unsigned* st) {
    XcdBarrier b; b.bar = bar; b.x = xb_xcc_id(); b.st = st;
    if (threadIdx.x == 0) (void)xb_add(&bar[XB_XCNT(b.x)], 1u);
    return b;
}
__device__ __forceinline__ void xcd_barrier_complete(unsigned* bar, unsigned x, unsigned& nloc, unsigned& nx) {
    const unsigned G = gridDim.x * gridDim.y * gridDim.z;
    unsigned sum, cnt, mine, sp = 0u;
    for (;;) {
        sum = 0u; cnt = 0u; mine = 0u;
#pragma unroll
        for (unsigned j = 0; j < 16; ++j) { const unsigned c = xb_ld(&bar[XB_XCNT(j)]); sum += c; cnt += (c > 0u) ? 1u : 0u; mine = (j == x) ? c : mine; }
        if (sum == G) break;
        __builtin_amdgcn_s_sleep(1);
        if ((++sp & 255u) == 0u) { if (xb_ld(&bar[XB_TMO])) break; if (sp > XB_SPIN_CAP) { atomicAdd(&bar[XB_TMO], 1u); break; } }
    }
    nloc = mine > 0u ? mine : 1u; nx = cnt > 0u ? cnt : 1u;
}

__device__ __forceinline__ void xcd_barrier(const XcdBarrier& b) {
    asm volatile("s_waitcnt vmcnt(0)" ::: "memory");
    __syncthreads();
    if (threadIdx.x == 0) {
        unsigned* bar = b.bar;
        __builtin_amdgcn_s_waitcnt(0);
        unsigned nloc = b.st[0], nx = b.st[1];
        if (nloc == 0u) { xcd_barrier_complete(bar, b.x, nloc, nx); b.st[0] = nloc; b.st[1] = nx; }
        const unsigned old = xb_add(&bar[XB_XSUB(b.x)], 1u);
        const unsigned gen = old / nloc;
        if (old + 1u == (gen + 1u) * nloc) {
            __builtin_amdgcn_fence(__ATOMIC_RELEASE, "agent");
            asm volatile("s_waitcnt vmcnt(0)" ::: "memory");
            const unsigned og = xb_add(&bar[XB_TOP], 1u);
            const unsigned tg = og / nx;
            if (og + 1u == (tg + 1u) * nx) xb_add(&bar[XB_TOPGEN], 1u);
            else XB_SPIN(xb_ld(&bar[XB_TOPGEN]) == tg, bar);
            __builtin_amdgcn_fence(__ATOMIC_ACQUIRE, "agent");
            xb_add(&bar[XB_XGEN(b.x)], 1u);
            asm volatile("s_waitcnt vmcnt(0)" ::: "memory");
        } else {
            XB_SPIN(xb_ld(&bar[XB_XGEN(b.x)]) == gen, bar);
            __builtin_amdgcn_fence(__ATOMIC_ACQUIRE, "agent");
            asm volatile("s_waitcnt vmcnt(0)" ::: "memory");
        }
    }
    __syncthreads();
}


typedef unsigned short bf16_t;
typedef short bf16x8 __attribute__((ext_vector_type(8)));
typedef short bf16x4 __attribute__((ext_vector_type(4)));
typedef float f32x4 __attribute__((ext_vector_type(4)));
typedef unsigned u32x4 __attribute__((ext_vector_type(4)));
typedef unsigned u32x2 __attribute__((ext_vector_type(2)));

constexpr int T_TOK = 16384, DMODEL = 4096, SEQ = 8192, NPROJ = 16384, NIN = 16416, NPAD = 16640;
constexpr int LDS_BYTES = 131072 + 16;
constexpr size_t OFF_XN = 0, OFF_WINT = 134217728ull, OFF_WOUTT = 270532608ull, OFF_PROJ = 304087040ull, OFF_GATE = 840957952ull,
                 OFF_MIXED = 843055104ull, OFF_AB = 977272832ull, OFF_LSE = 1010827264ull, OFF_CD = 1013972992ull, WS_END = 1013989376ull, WS_BAR = WS_END + (8ull << 20);
constexpr size_t OFF_WB = 0, OFF_UB = 67108864ull, OFF_QD = 134217728ull, OFF_KT = 201326592ull;
constexpr size_t OUT_OP = 0, OUT_ODN = 201326592ull;

struct Params {
    const float* x; const float* norm_g; const float* w_in; const float* conv_w; const float* a_log; const float* dt_bias; const float* dn_norm_g; const float* w_out; const float* final_g;
    float* out; unsigned char* ws; int mask; int coop;
};

typedef __bf16 bf16v2_t __attribute__((ext_vector_type(2)));
typedef float f32v2_t __attribute__((ext_vector_type(2)));
__device__ __forceinline__ unsigned cvt_pk(float lo, float hi) { f32v2_t v = {lo, hi}; bf16v2_t b = __builtin_convertvector(v, bf16v2_t); return __builtin_bit_cast(unsigned, b); }
__device__ __forceinline__ float bflo(unsigned w) { return __uint_as_float(w << 16); }
__device__ __forceinline__ float bfhi(unsigned w) { return __uint_as_float(w & 0xffff0000u); }
__device__ __forceinline__ float bf2f(bf16_t v) { return __uint_as_float(((unsigned)v) << 16); }
__device__ __forceinline__ bf16_t f2bf(float f) { return (bf16_t)(cvt_pk(f, 0.f) & 0xffffu); }
__device__ __forceinline__ float silu_f(float v) { return v / (1.0f + __expf(-v)); }
__device__ __forceinline__ f32x4 mfma32(bf16x8 a, bf16x8 b, f32x4 c) { return __builtin_amdgcn_mfma_f32_16x16x32_bf16(a, b, c, 0, 0, 0); }
__device__ __forceinline__ f32x4 mfma16(bf16x4 a, bf16x4 b, f32x4 c) { return __builtin_amdgcn_mfma_f32_16x16x16bf16_1k(a, b, c, 0, 0, 0); }

struct EpiProj {
    static constexpr bool PERM = true, AFTER_DRAIN = false;
    bf16_t* O; float* gate;
    __device__ __forceinline__ void operator()(const f32x4 (&acc)[2][2][4][2], const pg8::Unit& u, int wr, int wc, int fr, int fq) const {
        const int row0 = u.pm * 256 + wr * 64 + fr;
        if (u.pn < 64) {
            const int col0 = u.pn * 256 + wc * 32 + 8 * fq;
#pragma unroll
            for (int ai = 0; ai < 2; ++ai)
#pragma unroll
                for (int m = 0; m < 4; ++m) { bf16_t* rowp = O + (size_t)(row0 + ai * 128 + m * 16) * NPROJ + col0;
#pragma unroll
                    for (int bj = 0; bj < 2; ++bj) { const f32x4 v0 = acc[ai][bj][m][0], v1 = acc[ai][bj][m][1];
                        u32x4 w; w.x = cvt_pk(v0[0], v0[1]); w.y = cvt_pk(v0[2], v0[3]); w.z = cvt_pk(v1[0], v1[1]); w.w = cvt_pk(v1[2], v1[3]);
                        *(u32x4*)(rowp + bj * 128) = w; } }
        } else if (wc == 0) {
#pragma unroll
            for (int ai = 0; ai < 2; ++ai)
#pragma unroll
                for (int m = 0; m < 4; ++m) { float* gp = gate + (size_t)(row0 + ai * 128 + m * 16) * 32 + 8 * fq;
                    *(f32x4*)gp = acc[ai][0][m][0]; *(f32x4*)(gp + 4) = acc[ai][0][m][1]; }
        }
    }
};
struct EpiResid {
    static constexpr bool PERM = false, AFTER_DRAIN = false;
    float* C; const float* X;
    __device__ __forceinline__ void operator()(const f32x4 (&acc)[2][2][4][2], const pg8::Unit& u, int wr, int wc, int fr, int fq) const {
        const int row0 = u.pm * 256 + wr * 64 + fr, col0 = u.pn * 256 + wc * 32 + 4 * fq;
#pragma unroll
        for (int ai = 0; ai < 2; ++ai)
#pragma unroll
            for (int m = 0; m < 4; ++m) { const size_t off = (size_t)(row0 + ai * 128 + m * 16) * DMODEL + col0;
#pragma unroll
                for (int bj = 0; bj < 2; ++bj)
#pragma unroll
                    for (int n = 0; n < 2; ++n) { const f32x4 xv = *(const f32x4*)(X + off + bj * 128 + n * 16); *(f32x4*)(C + off + bj * 128 + n * 16) = acc[ai][bj][m][n] + xv; } }
    }
};

struct EpiResidBf {
    static constexpr bool PERM = true, AFTER_DRAIN = false;
    bf16_t* H; const float* X;
    __device__ __forceinline__ void operator()(const f32x4 (&acc)[2][2][4][2], const pg8::Unit& u, int wr, int wc, int fr, int fq) const {
        const int row0 = u.pm * 256 + wr * 64 + fr, col0 = u.pn * 256 + wc * 32 + 8 * fq;
#pragma unroll
        for (int ai = 0; ai < 2; ++ai)
#pragma unroll
            for (int m = 0; m < 4; ++m) { const size_t off = (size_t)(row0 + ai * 128 + m * 16) * DMODEL + col0;
#pragma unroll
                for (int bj = 0; bj < 2; ++bj) { const f32x4 x0 = __builtin_nontemporal_load((const f32x4*)(X + off + bj * 128)), x1 = __builtin_nontemporal_load((const f32x4*)(X + off + bj * 128 + 4));
                    const f32x4 v0 = acc[ai][bj][m][0] + x0, v1 = acc[ai][bj][m][1] + x1;
                    u32x4 w; w.x = cvt_pk(v0[0], v0[1]); w.y = cvt_pk(v0[2], v0[3]); w.z = cvt_pk(v1[0], v1[1]); w.w = cvt_pk(v1[2], v1[3]);
                    *(u32x4*)(H + off + bj * 128) = w; } }
    }
};
struct RepOrder : pg8::StaticOrder {
    int reps;
    __device__ bool next(int i, pg8::Unit& u) const {
        const long L = (long)i * G + c; if (L >= (long)nwg * reps) return false;
        int wgid = (int)(L % nwg); { const int q = nwg / pg8::NXCD, r = nwg % pg8::NXCD, xcd = wgid % pg8::NXCD, off = wgid / pg8::NXCD; wgid = (xcd < r ? xcd * (q + 1) : r * (q + 1) + (xcd - r) * q) + off; }
        const int nig = pg8::WGM * nN, gid = wgid / nig, fm = gid * pg8::WGM, gsz = (nM - fm) < pg8::WGM ? (nM - fm) : pg8::WGM;
        u.pm = fm + ((wgid % nig) % gsz); u.pn = nN - 1 - (wgid % nig) / gsz; return true;
    }
};
__device__ __forceinline__ float wave_sum(float v) {
#pragma unroll
    for (int o = 32; o >= 1; o >>= 1) v += __shfl_xor(v, o);
    return v;
}
__device__ void phase_rmsnorm_x(const float* __restrict__ x, const float* __restrict__ g, bf16_t* __restrict__ xn) {
    const int wid = threadIdx.x >> 6, lane = threadIdx.x & 63;
    const int gw = blockIdx.x * 8 + wid, nw = gridDim.x * 8;
    for (int row = gw; row < T_TOK; row += nw) {
        const f32x4* xr = (const f32x4*)(x + (size_t)row * DMODEL);
        f32x4 v[16]; float ss = 0.f;
#pragma unroll
        for (int i = 0; i < 16; ++i) { v[i] = __builtin_nontemporal_load(xr + i * 64 + lane); ss += v[i][0] * v[i][0] + v[i][1] * v[i][1] + v[i][2] * v[i][2] + v[i][3] * v[i][3]; }
        ss = wave_sum(ss);
        const float rstd = rsqrtf(ss * (1.0f / DMODEL) + 1e-6f);
        bf16_t* orow = xn + (size_t)row * DMODEL;
#pragma unroll
        for (int i = 0; i < 16; ++i) { const f32x4 gg = ((const f32x4*)g)[i * 64 + lane]; u32x2 w; w.x = cvt_pk(v[i][0] * rstd * gg[0], v[i][1] * rstd * gg[1]); w.y = cvt_pk(v[i][2] * rstd * gg[2], v[i][3] * rstd * gg[3]);
            *(u32x2*)(orow + (i * 64 + lane) * 4) = w; }
    }
}
__device__ void phase_transpose(LAS unsigned char* lds, const float* __restrict__ W, int K, int N, int Npad, bf16_t* __restrict__ Wt) {
    const int wid = threadIdx.x >> 6, lane = threadIdx.x & 63;
    const int gw = blockIdx.x * 8 + wid, nw = gridDim.x * 8;
    const int nkt = K / 64, total = nkt * (Npad / 32);
    LAS bf16_t* tl = (LAS bf16_t*)(lds + wid * 4352);
    const int c4 = lane & 7, kr = lane >> 3, rn = lane >> 1, half = lane & 1;
    for (int tile = gw; tile < total; tile += nw) {
        const int nnt = Npad / 32, kt = tile / nnt, nt = tile - kt * nnt, n0 = nt * 32, k0 = kt * 64;
        const int n = n0 + 4 * c4;
#pragma unroll
        for (int it = 0; it < 8; ++it) { const int k = it * 8 + kr;
            f32x4 v = (f32x4){0.f, 0.f, 0.f, 0.f};
            if (n < N) v = __builtin_nontemporal_load((const f32x4*)(W + (size_t)(k0 + k) * N + n));
            const unsigned p0 = cvt_pk(v[0], v[1]), p1 = cvt_pk(v[2], v[3]);
            tl[(4 * c4 + 0) * 66 + k] = (bf16_t)(p0 & 0xffffu); tl[(4 * c4 + 1) * 66 + k] = (bf16_t)(p0 >> 16);
            tl[(4 * c4 + 2) * 66 + k] = (bf16_t)(p1 & 0xffffu); tl[(4 * c4 + 3) * 66 + k] = (bf16_t)(p1 >> 16); }
        asm volatile("s_waitcnt lgkmcnt(0)" ::: "memory");
        __builtin_amdgcn_wave_barrier();
        const LAS unsigned* rp = (const LAS unsigned*)(tl + rn * 66 + 32 * half);
        unsigned d[16];
#pragma unroll
        for (int i = 0; i < 16; ++i) d[i] = rp[i];
        bf16_t* op = Wt + (size_t)(n0 + rn) * K + k0 + 32 * half;
#pragma unroll
        for (int i = 0; i < 4; ++i) *(u32x4*)(op + 8 * i) = (u32x4){d[4 * i], d[4 * i + 1], d[4 * i + 2], d[4 * i + 3]};
        asm volatile("s_waitcnt lgkmcnt(0)" ::: "memory");
        __builtin_amdgcn_wave_barrier();
    }
}

__device__ __forceinline__ void gate_gemm(LAS unsigned char* lds, const bf16_t* __restrict__ xn, const bf16_t* __restrict__ WinT, float* __restrict__ gate, int rb) {
    const int tid = threadIdx.x, wid = tid >> 6, lane = tid & 63, fr = lane & 15, g = lane >> 4;
    f32x4 acc[4][2];
#pragma unroll
    for (int mt = 0; mt < 4; ++mt) { acc[mt][0] = (f32x4){0.f, 0.f, 0.f, 0.f}; acc[mt][1] = (f32x4){0.f, 0.f, 0.f, 0.f}; }
    const bf16_t* arow = xn + (size_t)(rb * 64 + fr) * DMODEL + wid * 512 + 8 * g;
    const bf16_t* brow = WinT + (size_t)(NPROJ + fr) * DMODEL + wid * 512 + 8 * g;
#pragma unroll 4
    for (int ks = 0; ks < 16; ++ks) {
        bf16x8 a[4], b[2];
#pragma unroll
        for (int mt = 0; mt < 4; ++mt) a[mt] = *(const bf16x8*)(arow + (size_t)(16 * mt) * DMODEL + 32 * ks);
#pragma unroll
        for (int nt = 0; nt < 2; ++nt) b[nt] = *(const bf16x8*)(brow + (size_t)(16 * nt) * DMODEL + 32 * ks);
#pragma unroll
        for (int mt = 0; mt < 4; ++mt)
#pragma unroll
            for (int nt = 0; nt < 2; ++nt) acc[mt][nt] = mfma32(a[mt], b[nt], acc[mt][nt]);
    }
    LAS float* red = (LAS float*)lds;
#pragma unroll
    for (int mt = 0; mt < 4; ++mt)
#pragma unroll
        for (int nt = 0; nt < 2; ++nt)
#pragma unroll
            for (int reg = 0; reg < 4; ++reg) red[(wid * 64 + 16 * mt + 4 * g + reg) * 32 + 16 * nt + fr] = acc[mt][nt][reg];
    __syncthreads();
#pragma unroll
    for (int i = 0; i < 4; ++i) { const int e = tid + 512 * i; float s = 0.f;
#pragma unroll
        for (int w = 0; w < 8; ++w) s += red[w * 2048 + e];
        gate[(size_t)(rb * 64) * 32 + e] = s; }
    __syncthreads();
}

constexpr int N_ATTN_TASKS = 3 * 2 * 16 * 64;
#define LDS_BARRIER() do { asm volatile("s_waitcnt lgkmcnt(0)" ::: "memory"); __builtin_amdgcn_s_barrier(); asm volatile("" ::: "memory"); } while (0)
struct AttnPre { u32x4 k[8], v[8]; bf16x8 q[4]; };
struct AttnTask { int p, b, h, n, dil, tb; };
__device__ __forceinline__ AttnTask attn_decode(int task) {
    AttnTask t; t.p = task >> 11; const int rem = task & 2047; t.b = rem >> 10; t.h = (rem >> 6) & 15; const int idx = rem & 63;
    const int dsh = 2 * t.p, nbp = 64 >> dsh; t.dil = 1 << dsh; const int r = idx >> (6 - dsh); t.n = idx & (nbp - 1); t.tb = t.b * SEQ + r; return t;
}
__device__ __forceinline__ void attn_prefetch(AttnPre& P, const bf16_t* __restrict__ proj, int task, bool cont, int tid) {
    const AttnTask t = attn_decode(task);
    const int jb = cont ? 128 : 0;
#pragma unroll
    for (int i = 0; i < 4; ++i) {
        const int c = tid + 512 * i, j = jb + (c >> 4), ch = c & 15, idxk = (t.n - 1) * 128 + j;
        const bf16_t* rowp = proj + (size_t)(t.tb + (idxk < 0 ? 0 : idxk) * t.dil) * NPROJ + t.h * 128 + ch * 8;
        P.k[i] = *(const u32x4*)(rowp + 2048); P.v[i] = *(const u32x4*)(rowp + 4096);
    }
    if (!cont) {
#pragma unroll
        for (int i = 4; i < 8; ++i) {
            const int c = tid + 512 * i, j = c >> 4, ch = c & 15, idxk = (t.n - 1) * 128 + j;
            const bf16_t* rowp = proj + (size_t)(t.tb + (idxk < 0 ? 0 : idxk) * t.dil) * NPROJ + t.h * 128 + ch * 8;
            P.k[i] = *(const u32x4*)(rowp + 2048); P.v[i] = *(const u32x4*)(rowp + 4096);
        }
    }
    { const int wid = tid >> 6, lane = tid & 63, fr = lane & 15, g = lane >> 4;
      const bf16_t* qrow = proj + (size_t)(t.tb + (t.n * 128 + 16 * wid + fr) * t.dil) * NPROJ + t.h * 128;
#pragma unroll
      for (int s = 0; s < 4; ++s) P.q[s] = *(const bf16x8*)(qrow + 32 * s + 8 * g); }
}
__device__ __forceinline__ void attn_compute(LAS unsigned char* lds, const bf16_t* __restrict__ proj, bf16_t* __restrict__ op, float* __restrict__ lsep, int task, int next_task, bool cont, bool next_cont, int par, AttnPre& P) {
    const int tid = threadIdx.x, wid = tid >> 6, lane = tid & 63, fr = lane & 15, g = lane >> 4;
    const AttnTask t = attn_decode(task);
    const int p = t.p, h = t.h, n = t.n, dil = t.dil, px = par << 7;
    const float slope = exp2f(-0.5f * (float)(h + 1));
    { const int jb = cont ? 128 : 0;
#pragma unroll
      for (int i = 0; i < 4; ++i) {
          const int c = tid + 512 * i, j = jb + (c >> 4), ch = c & 15, idxk = (n - 1) * 128 + j, jp = j ^ px;
          u32x4 kv = P.k[i], vv = P.v[i];
          if (idxk < 0) { kv = (u32x4){0u, 0u, 0u, 0u}; vv = (u32x4){0u, 0u, 0u, 0u}; }
          *(LAS u32x4*)(lds + jp * 256 + ((ch ^ (j & 15)) << 4)) = kv;
          *(LAS u32x4*)(lds + 65536 + jp * 256 + ((ch ^ ((j & 7) << 1)) << 4)) = vv;
      }
      if (!cont) {
#pragma unroll
          for (int i = 4; i < 8; ++i) {
              const int c = tid + 512 * i, j = c >> 4, ch = c & 15, idxk = (n - 1) * 128 + j, jp = j ^ px;
              u32x4 kv = P.k[i], vv = P.v[i];
              if (idxk < 0) { kv = (u32x4){0u, 0u, 0u, 0u}; vv = (u32x4){0u, 0u, 0u, 0u}; }
              *(LAS u32x4*)(lds + jp * 256 + ((ch ^ (j & 15)) << 4)) = kv;
              *(LAS u32x4*)(lds + 65536 + jp * 256 + ((ch ^ ((j & 7) << 1)) << 4)) = vv;
          }
      } }
    const int tq = t.tb + (n * 128 + 16 * wid + fr) * dil;
    bf16x8 qf[4];
#pragma unroll
    for (int s = 0; s < 4; ++s) qf[s] = P.q[s];
    LDS_BARRIER();
    if (next_task >= 0) attn_prefetch(P, proj, next_task, next_cont, tid);
    float sc[9][4];
    float mx = -1e30f;
#pragma unroll
    for (int kt9 = 0; kt9 < 9; ++kt9) {
        const int kt = wid + kt9, jr = (16 * kt) ^ px;
        f32x4 acc = (f32x4){0.f, 0.f, 0.f, 0.f};
#pragma unroll
        for (int s = 0; s < 4; ++s) { const bf16x8 kf = *(const LAS bf16x8*)(lds + (jr + fr) * 256 + (((4 * s + g) ^ fr) << 4)); acc = mfma32(kf, qf[s], acc); }
#pragma unroll
        for (int reg = 0; reg < 4; ++reg) { const int j = 16 * kt + 4 * g + reg, l = 16 * wid + fr, dist = l + 128 - j;
            const bool valid = (dist >= 0) && (dist <= 128) && (n > 0 || j >= 128);
            const float v = valid ? acc[reg] * 0.08838834764831845f - slope * (float)(dist * dil) : -1e30f;
            sc[kt9][reg] = v; mx = fmaxf(mx, v); }
    }
    mx = fmaxf(mx, __shfl_xor(mx, 16)); mx = fmaxf(mx, __shfl_xor(mx, 32));
    float sum = 0.f;
    bf16x4 pk[9];
#pragma unroll
    for (int kt9 = 0; kt9 < 9; ++kt9) {
        float e[4];
#pragma unroll
        for (int reg = 0; reg < 4; ++reg) { e[reg] = __expf(sc[kt9][reg] - mx); sum += e[reg]; }
        u32x2 w; w.x = cvt_pk(e[0], e[1]); w.y = cvt_pk(e[2], e[3]);
        pk[kt9] = __builtin_bit_cast(bf16x4, w);
    }
    sum += __shfl_xor(sum, 16); sum += __shfl_xor(sum, 32);
    const float inv = 1.0f / sum, lse = mx + __logf(sum);
    bf16_t* orow = op + ((size_t)p * T_TOK + tq) * 2048 + h * 128;
    const int tq4 = fr >> 2, tp4 = fr & 3, krow = 4 * g + tq4;
    const unsigned vbase = (unsigned)(size_t)lds + 65536u + (unsigned)(krow * 256 + 8 * (tp4 & 1));
    unsigned rt[9];
#pragma unroll
    for (int kt9 = 0; kt9 < 9; ++kt9) rt[kt9] = (unsigned)(((16 * (wid + kt9)) ^ px) * 256);
#pragma unroll
    for (int dt = 0; dt < 8; ++dt) {
        f32x4 acc = (f32x4){0.f, 0.f, 0.f, 0.f};
        const unsigned va = vbase + (unsigned)((((2 * dt + (tp4 >> 1)) ^ ((krow & 7) << 1))) << 4);
        unsigned ad[9];
#pragma unroll
        for (int kt9 = 0; kt9 < 9; ++kt9) ad[kt9] = va + rt[kt9];
        u32x2 vt[9];
        asm volatile("ds_read_b64_tr_b16 %0, %9\n\tds_read_b64_tr_b16 %1, %10\n\tds_read_b64_tr_b16 %2, %11\n\tds_read_b64_tr_b16 %3, %12\n\t"
                     "ds_read_b64_tr_b16 %4, %13\n\tds_read_b64_tr_b16 %5, %14\n\tds_read_b64_tr_b16 %6, %15\n\tds_read_b64_tr_b16 %7, %16\n\t"
                     "ds_read_b64_tr_b16 %8, %17\n\ts_waitcnt lgkmcnt(0)"
                     : "=&v"(vt[0]), "=&v"(vt[1]), "=&v"(vt[2]), "=&v"(vt[3]), "=&v"(vt[4]), "=&v"(vt[5]), "=&v"(vt[6]), "=&v"(vt[7]), "=&v"(vt[8])
                     : "v"(ad[0]), "v"(ad[1]), "v"(ad[2]), "v"(ad[3]), "v"(ad[4]), "v"(ad[5]), "v"(ad[6]), "v"(ad[7]), "v"(ad[8]) : "memory");
#pragma unroll
        for (int kt9 = 0; kt9 < 9; ++kt9) acc = mfma16(__builtin_bit_cast(bf16x4, vt[kt9]), pk[kt9], acc);
        u32x2 w; w.x = cvt_pk(acc[0] * inv, acc[1] * inv); w.y = cvt_pk(acc[2] * inv, acc[3] * inv);
        *(u32x2*)(orow + 16 * dt + 4 * g) = w;
    }
    if (g == 0) lsep[((size_t)p * T_TOK + tq) * 16 + h] = lse;
    LDS_BARRIER();
}
__device__ __forceinline__ void attn_phase(LAS unsigned char* lds, const bf16_t* __restrict__ proj, bf16_t* __restrict__ op, float* __restrict__ lsep, int t0, int t1) {
    const int tid = threadIdx.x;
    if (t0 >= t1) return;
    AttnPre P;
    attn_prefetch(P, proj, t0, false, tid);
    int par = 0; bool cont = false;
    for (int task = t0; task < t1; ++task) {
        const int nxt = task + 1 < t1 ? task + 1 : -1;
        const bool next_cont = nxt >= 0 && attn_decode(nxt).n > 0;
        attn_compute(lds, proj, op, lsep, task, nxt, cont, next_cont, par, P);
        cont = next_cont; par = next_cont ? (par ^ 1) : 0;
    }
    __syncthreads();
}

constexpr int DN_Q = 0, DN_K = 17408, DN_V = 34816, DN_AD = 52224, DN_ABF = 56320, DN_TBF = 65536, DN_GC = 68608, DN_BETA = 68864, DN_EG = 69120, DN_CW = 69376;
__device__ void dn_stage_convw(LAS unsigned char* lds, const float* __restrict__ conv_w, int h) {
    LAS float* cw_s = (LAS float*)(lds + DN_CW);
    for (int e = threadIdx.x; e < 1536; e += 512) { const int j = e / 384, r = e - j * 384, X = r >> 7, col = r & 127; cw_s[e] = conv_w[j * 6144 + X * 2048 + h * 128 + col]; }
    __syncthreads();
}
template <int X> __device__ __forceinline__ void dn_conv_block(LAS unsigned char* lds, const LAS float* cw_s, const u32x4 (&xin)[2][4], int s0, int i, int cg8) {
    float y[16];
#pragma unroll
    for (int hf = 0; hf < 2; ++hf) {
        float acc[8];
#pragma unroll
        for (int e = 0; e < 8; ++e) acc[e] = 0.f;
#pragma unroll
        for (int j = 0; j < 4; ++j) { const int sp = s0 + i - 3 + j; const float mj = sp >= 0 ? 1.0f : 0.0f;
            const u32x4 xv = xin[hf][j];
            const f32x4 w0 = *(const LAS f32x4*)(cw_s + j * 384 + X * 128 + 16 * cg8 + 8 * hf) * mj, w1 = *(const LAS f32x4*)(cw_s + j * 384 + X * 128 + 16 * cg8 + 8 * hf + 4) * mj;
            acc[0] += w0[0] * bflo(xv.x); acc[1] += w0[1] * bfhi(xv.x); acc[2] += w0[2] * bflo(xv.y); acc[3] += w0[3] * bfhi(xv.y);
            acc[4] += w1[0] * bflo(xv.z); acc[5] += w1[1] * bfhi(xv.z); acc[6] += w1[2] * bflo(xv.w); acc[7] += w1[3] * bfhi(xv.w); }
#pragma unroll
        for (int e = 0; e < 8; ++e) y[hf * 8 + e] = silu_f(acc[e]);
        asm volatile("" ::: "memory");
    }
    if (X < 2) { float ss = 0.f;
#pragma unroll
        for (int e = 0; e < 16; ++e) ss += y[e] * y[e];
        ss += __shfl_xor(ss, 1); ss += __shfl_xor(ss, 2); ss += __shfl_xor(ss, 4);
        const float scl = rsqrtf(ss + 1e-6f) * (X == 0 ? 0.08838834764831845f : 1.0f);
#pragma unroll
        for (int e = 0; e < 16; ++e) y[e] *= scl; }
    LAS u32x4* dst = (LAS u32x4*)(lds + X * 17408 + i * 272 + cg8 * 32);
    dst[0] = (u32x4){cvt_pk(y[0], y[1]), cvt_pk(y[2], y[3]), cvt_pk(y[4], y[5]), cvt_pk(y[6], y[7])};
    dst[1] = (u32x4){cvt_pk(y[8], y[9]), cvt_pk(y[10], y[11]), cvt_pk(y[12], y[13]), cvt_pk(y[14], y[15])};
}
struct PrepPre { u32x4 x[2][2][4]; float bl, al, alog, dtb; };
__device__ __forceinline__ void dn_prep_prefetch(PrepPre& P, const bf16_t* __restrict__ proj, const float* __restrict__ gate, const float* __restrict__ a_log, const float* __restrict__ dt_bias, int chunk) {
    const int tid = threadIdx.x, wid = tid >> 6, lane = tid & 63;
    const int bh = chunk >> 7, n = chunk & 127, b = bh >> 4, h = bh & 15, s0 = n * 64, i = tid >> 3, cg8 = tid & 7;
#pragma unroll
    for (int X = 0; X < 2; ++X)
#pragma unroll
        for (int hf = 0; hf < 2; ++hf)
#pragma unroll
            for (int j = 0; j < 4; ++j) { const int sp = s0 + i - 3 + j;
                P.x[X][hf][j] = *(const u32x4*)(proj + ((size_t)b * SEQ + (sp < 0 ? 0 : sp)) * NPROJ + 8192 + X * 2048 + h * 128 + 16 * cg8 + 8 * hf); }
    if (wid == 0) { const size_t t0 = (size_t)b * SEQ + s0; P.bl = gate[(t0 + lane) * 32 + h]; P.al = gate[(t0 + lane) * 32 + 16 + h]; P.alog = a_log[h]; P.dtb = dt_bias[h]; }
}
__device__ __forceinline__ void dn_prep_chunk(LAS unsigned char* lds, const bf16_t* __restrict__ proj, const float* __restrict__ gate, const float* __restrict__ a_log, const float* __restrict__ dt_bias,
                              bf16_t* __restrict__ Wb, bf16_t* __restrict__ Uf, bf16_t* __restrict__ Qd, bf16_t* __restrict__ Kt, bf16_t* __restrict__ Ab, float* __restrict__ Cd, int chunk, int next_chunk, PrepPre& P) {
    int tid_ = threadIdx.x; asm volatile("" : "+v"(tid_));
    const int tid = tid_, wid = tid >> 6, lane = tid & 63, fr = lane & 15, g = lane >> 4;
    const int bh = chunk >> 7, n = chunk & 127, b = bh >> 4, h = bh & 15;
    const int s0 = n * 64;
    LAS float* cw_s = (LAS float*)(lds + DN_CW);
    LAS float* Ad = (LAS float*)(lds + DN_AD); LAS float* gc_s = (LAS float*)(lds + DN_GC); LAS float* beta_s = (LAS float*)(lds + DN_BETA); LAS float* eg_s = (LAS float*)(lds + DN_EG);
    {
        const int i = tid >> 3, cg8 = tid & 7;
        u32x4 xv2[2][4];
#pragma unroll
        for (int hf = 0; hf < 2; ++hf)
#pragma unroll
            for (int j = 0; j < 4; ++j) { const int sp = s0 + i - 3 + j;
                xv2[hf][j] = *(const u32x4*)(proj + ((size_t)b * SEQ + (sp < 0 ? 0 : sp)) * NPROJ + 8192 + 2 * 2048 + h * 128 + 16 * cg8 + 8 * hf); }
        dn_conv_block<0>(lds, cw_s, P.x[0], s0, i, cg8);
        dn_conv_block<1>(lds, cw_s, P.x[1], s0, i, cg8);
        dn_conv_block<2>(lds, cw_s, xv2, s0, i, cg8);
    }
    if (wid == 0) {
        const float beta = 1.0f / (1.0f + expf(-P.bl));
        const float xx = P.al + P.dtb;
        const float sp = xx > 20.f ? xx : log1pf(expf(xx));
        float gc = -expf(P.alog) * sp;
#pragma unroll
        for (int off = 1; off < 64; off <<= 1) { const float v = __shfl_up(gc, off); if (lane >= off) gc += v; }
        gc_s[lane] = gc; beta_s[lane] = beta; eg_s[lane] = expf(gc);
    }
    LDS_BARRIER();
    if (next_chunk >= 0) dn_prep_prefetch(P, proj, gate, a_log, dt_bias, next_chunk);
    {
        const int type = wid >> 2, ti = wid & 3;
        const int i = 16 * ti + fr; const float gi = gc_s[i], bi = beta_s[i];
#pragma unroll
        for (int tj = 0; tj < 4; ++tj) {
            const size_t aoff = (size_t)chunk * 4096 + ((ti * 2 + (tj >> 1)) * 64 + (2 * (tj & 1) + (g >> 1)) * 16 + fr) * 8 + 4 * (g & 1);
            if (tj > ti) { if (type == 1) *(u32x2*)(Ab + aoff) = (u32x2){0u, 0u}; continue; }
            f32x4 acc = (f32x4){0.f, 0.f, 0.f, 0.f};
            const int xoff = type == 0 ? DN_K : DN_Q;
#pragma unroll
            for (int s = 0; s < 4; ++s) { const bf16x8 a = *(const LAS bf16x8*)(lds + DN_K + (16 * tj + fr) * 272 + (32 * s + 8 * g) * 2), bb = *(const LAS bf16x8*)(lds + xoff + i * 272 + (32 * s + 8 * g) * 2); acc = mfma32(a, bb, acc); }
            float v[4];
#pragma unroll
            for (int reg = 0; reg < 4; ++reg) { const int j = 16 * tj + 4 * g + reg; const float e = __expf(fminf(gi - gc_s[j], 0.f));
                v[reg] = type == 0 ? ((i > j) ? -bi * acc[reg] * e : 0.f) : ((i >= j) ? acc[reg] * e : 0.f); }
            if (type == 1) *(u32x2*)(Ab + aoff) = (u32x2){cvt_pk(v[0], v[1]), cvt_pk(v[2], v[3])};
            else if (tj == ti) *(LAS f32x4*)(Ad + (ti * 16 + fr) * 16 + 4 * g) = (f32x4){-v[0], -v[1], -v[2], -v[3]};
            else *(LAS u32x2*)(lds + DN_ABF + i * 144 + (16 * tj + 4 * g) * 2) = (u32x2){cvt_pk(v[0], v[1]), cvt_pk(v[2], v[3])};
        }
    }
    LDS_BARRIER();
    if (wid == 0) {
        const int bb = lane >> 4, c = lane & 15;
        float t[16];
#pragma unroll
        for (int i = 0; i < 16; ++i) {
            float acc = (i == c) ? 1.0f : 0.0f;
#pragma unroll
            for (int jj = 0; jj < (i + 3) / 4; ++jj) { const f32x4 a4 = *(const LAS f32x4*)(Ad + (bb * 16 + i) * 16 + 4 * jj);
#pragma unroll
                for (int e = 0; e < 4; ++e) if (4 * jj + e < i) acc -= a4[e] * t[4 * jj + e]; }
            t[i] = acc;
            *(LAS bf16_t*)(lds + DN_TBF + ((bb * 16 + i) * 24 + c) * 2) = f2bf(acc);
        }
    } else {
        for (int it = tid - 64; it < 512; it += 448) {
            if (it < 256) { const int i = it >> 2, part = it & 3; const float e = eg_s[i];
#pragma unroll
                for (int c4 = 0; c4 < 4; ++c4) { const u32x4 qv = *(const LAS u32x4*)(lds + DN_Q + i * 272 + part * 64 + c4 * 16);
                    u32x4 o; o.x = cvt_pk(bflo(qv.x) * e, bfhi(qv.x) * e); o.y = cvt_pk(bflo(qv.y) * e, bfhi(qv.y) * e); o.z = cvt_pk(bflo(qv.z) * e, bfhi(qv.z) * e); o.w = cvt_pk(bflo(qv.w) * e, bfhi(qv.w) * e);
                    *(u32x4*)(Qd + (size_t)chunk * 8192 + (((i >> 4) * 4 + part) * 64 + c4 * 16 + (i & 15)) * 8) = o; }
            } else { const int t2 = it - 256, d = t2 & 127, ih = t2 >> 7; const float gl = gc_s[63]; const LAS bf16_t* ks = (const LAS bf16_t*)(lds + DN_K) + d;
#pragma unroll
                for (int i8 = 0; i8 < 4; ++i8) { float v[8];
#pragma unroll
                    for (int e = 0; e < 8; ++e) { const int i = 32 * ih + 8 * i8 + e; v[e] = bf2f(ks[i * 136]) * __expf(gl - gc_s[i]); }
                    *(u32x4*)(Kt + (size_t)chunk * 8192 + (((d >> 4) * 2 + ih) * 64 + i8 * 16 + (d & 15)) * 8) = (u32x4){cvt_pk(v[0], v[1]), cvt_pk(v[2], v[3]), cvt_pk(v[4], v[5]), cvt_pk(v[6], v[7])}; } }
        }
        if (tid == 64) Cd[chunk] = expf(gc_s[63]);
    }
    LDS_BARRIER();
#pragma unroll
    for (int cc = 0; cc < 2; ++cc) {
        const int ct = 2 * wid + cc; const bool isu = ct < 8;
        const LAS bf16_t* src = (const LAS bf16_t*)(lds + (isu ? DN_V : DN_K)) + 16 * (ct & 7) + fr;
        bf16x4 Xb[4];
#pragma unroll
        for (int I = 0; I < 4; ++I) {
            f32x4 acc;
#pragma unroll
            for (int reg = 0; reg < 4; ++reg) { const int i = 16 * I + 4 * g + reg; float r = bf2f(src[i * 136]) * beta_s[i]; if (!isu) r *= eg_s[i]; acc[reg] = r; }
#pragma unroll
            for (int J = 0; J < I; ++J) { const bf16x4 a = *(const LAS bf16x4*)(lds + DN_ABF + (16 * I + fr) * 144 + (16 * J + 4 * g) * 2); acc = mfma16(a, Xb[J], acc); }
            const u32x2 yw = (u32x2){cvt_pk(acc[0], acc[1]), cvt_pk(acc[2], acc[3])};
            const bf16x4 tt = *(const LAS bf16x4*)(lds + DN_TBF + ((I * 16 + fr) * 24 + 4 * g) * 2);
            const f32x4 x = mfma16(tt, __builtin_bit_cast(bf16x4, yw), (f32x4){0.f, 0.f, 0.f, 0.f});
            const u32x2 xw = (u32x2){cvt_pk(x[0], x[1]), cvt_pk(x[2], x[3])};
            Xb[I] = __builtin_bit_cast(bf16x4, xw);
            if (isu) *(u32x2*)(Uf + ((((size_t)chunk * 8 + ct) * 4 + I) * 64 + lane) * 4) = xw;
            else {
#pragma unroll
                for (int reg = 0; reg < 4; ++reg) Wb[(size_t)chunk * 8192 + ((I * 4 + ((16 * (ct - 8) + fr) >> 5)) * 64 + (((16 * (ct - 8) + fr) >> 3) & 3) * 16 + 4 * g + reg) * 8 + (fr & 7)] = (bf16_t)(reg & 1 ? (reg & 2 ? xw.y >> 16 : xw.x >> 16) : (reg & 2 ? xw.y & 0xffffu : xw.x & 0xffffu));
            }
        }
    }
    LDS_BARRIER();
}

struct ScanRegs { bf16x8 f1[4], af[2], kf[2]; u32x2 uv; float cd; };
__device__ __forceinline__ void scan_load(ScanRegs& R, const bf16_t* __restrict__ Wb, const bf16_t* __restrict__ Uf, const bf16_t* __restrict__ Qd, const bf16_t* __restrict__ Kt, const bf16_t* __restrict__ Ab, const float* __restrict__ Cd,
                                          int chunk, int wid, int lane, int fr, int g, int sl) {
    const int tt = wid & 3;
    const bf16_t* src = (wid < 4 ? Wb : Qd) + (size_t)chunk * 8192 + (tt * 4 * 64 + lane) * 8;
#pragma unroll
    for (int s = 0; s < 4; ++s) R.f1[s] = *(const bf16x8*)(src + s * 512);
    R.uv = *(const u32x2*)(Uf + ((((size_t)chunk * 8 + sl) * 4 + tt) * 64 + lane) * 4);
#pragma unroll
    for (int s = 0; s < 2; ++s) R.af[s] = *(const bf16x8*)(Ab + (size_t)chunk * 4096 + ((tt * 2 + s) * 64 + lane) * 8);
#pragma unroll
    for (int s = 0; s < 2; ++s) R.kf[s] = *(const bf16x8*)(Kt + (size_t)chunk * 8192 + ((wid * 2 + s) * 64 + lane) * 8);
    R.cd = Cd[chunk];
}
__device__ __forceinline__ void scan_step(LAS unsigned char* lds, const ScanRegs& R, f32x4& Sacc, bf16_t* __restrict__ orow, size_t ostride, int wid, int fr, int g) {
    f32x4 acc = (f32x4){0.f, 0.f, 0.f, 0.f};
#pragma unroll
    for (int s = 0; s < 4; ++s) { const bf16x8 sf = *(const LAS bf16x8*)(lds + fr * 272 + (32 * s + 8 * g) * 2); acc = mfma32(R.f1[s], sf, acc); }
    const int voff = wid < 4 ? 4352 + fr * 144 + (16 * wid + 4 * g) * 2 : 8192 + (wid * 64 + g * 16 + fr) * 8;
    *(LAS u32x2*)(lds + voff) = (u32x2){cvt_pk(bflo(R.uv.x) - acc[0], bfhi(R.uv.x) - acc[1]), cvt_pk(bflo(R.uv.y) - acc[2], bfhi(R.uv.y) - acc[3])};
    LDS_BARRIER();
    const bf16x8 v0 = *(const LAS bf16x8*)(lds + 4352 + fr * 144 + (8 * g) * 2), v1 = *(const LAS bf16x8*)(lds + 4352 + fr * 144 + (32 + 8 * g) * 2);
    Sacc = Sacc * R.cd;
    Sacc = mfma32(R.kf[0], v0, Sacc); Sacc = mfma32(R.kf[1], v1, Sacc);
    *(LAS u32x2*)(lds + fr * 272 + (16 * wid + 4 * g) * 2) = (u32x2){cvt_pk(Sacc[0], Sacc[1]), cvt_pk(Sacc[2], Sacc[3])};
    acc = mfma32(R.af[0], v0, acc); acc = mfma32(R.af[1], v1, acc);
#pragma unroll
    for (int reg = 0; reg < 4; ++reg) orow[(size_t)reg * ostride] = f2bf(acc[reg]);
    LDS_BARRIER();
}
__device__ void dn_scan_item(LAS unsigned char* lds, const bf16_t* __restrict__ Wb, const bf16_t* __restrict__ Uf, const bf16_t* __restrict__ Qd, const bf16_t* __restrict__ Kt, const bf16_t* __restrict__ Ab, const float* __restrict__ Cd,
                             bf16_t* __restrict__ Odn, bf16_t* __restrict__ dump, int item) {
    const int tid = threadIdx.x, wid = __builtin_amdgcn_readfirstlane(tid >> 6), lane = tid & 63, fr = lane & 15, g = lane >> 4;
    const int bh = (item & 7) + 8 * (item >> 6), sl = (item >> 3) & 7, b = bh >> 4, h = bh & 15;
    f32x4 Sacc = (f32x4){0.f, 0.f, 0.f, 0.f};
    *(LAS u32x2*)(lds + fr * 272 + (16 * wid + 4 * g) * 2) = (u32x2){0u, 0u};
    __syncthreads();
    const int c0 = bh * 128;
    bf16_t* obase = wid >= 4 ? Odn + ((size_t)b * SEQ + 16 * (wid - 4) + 4 * g) * 2048 + h * 128 + 16 * sl + fr : dump + ((size_t)blockIdx.x * 8 + wid) * 64;
    const size_t ostride = wid >= 4 ? 2048 : 0, ostep = wid >= 4 ? (size_t)64 * 2048 : 0;
    ScanRegs R0, R1, R2, R3, R4;
#define SLOAD(R, n) scan_load(R, Wb, Uf, Qd, Kt, Ab, Cd, c0 + (n), wid, lane, fr, g, sl)
#define SSTEP(RC, RP, n) if ((n) < 128) { if ((n) + 4 < 128) SLOAD(RP, (n) + 4); scan_step(lds, RC, Sacc, obase + (size_t)(n) * ostep, ostride, wid, fr, g); }
    SLOAD(R0, 0); SLOAD(R1, 1); SLOAD(R2, 2); SLOAD(R3, 3);
    for (int n = 0; n < 128; n += 5) {
        SSTEP(R0, R4, n) SSTEP(R1, R0, n + 1) SSTEP(R2, R1, n + 2) SSTEP(R3, R2, n + 3) SSTEP(R4, R3, n + 4)
    }
#undef SLOAD
#undef SSTEP
    __syncthreads();
}

__device__ void phase_finalize(const bf16_t* __restrict__ proj, const bf16_t* __restrict__ op, const float* __restrict__ lsep, const bf16_t* __restrict__ Odn, const float* __restrict__ dn_g, bf16_t* __restrict__ mixed) {
    const int tid = threadIdx.x, sub = tid & 15;
    f32x4 g0 = *(const f32x4*)(dn_g + sub * 8), g1 = *(const f32x4*)(dn_g + sub * 8 + 4);
    for (int base = blockIdx.x * 32; base < T_TOK * 16; base += gridDim.x * 32) {
        const int pi = base + (tid >> 4), t = pi >> 4, h = pi & 15;
        { const float l0 = lsep[((size_t)0 * T_TOK + t) * 16 + h], l1 = lsep[((size_t)1 * T_TOK + t) * 16 + h], l2 = lsep[((size_t)2 * T_TOK + t) * 16 + h];
          const float m = fmaxf(l0, fmaxf(l1, l2)); float e0 = __expf(l0 - m), e1 = __expf(l1 - m), e2 = __expf(l2 - m); const float inv = 1.0f / (e0 + e1 + e2); e0 *= inv; e1 *= inv; e2 *= inv;
          const size_t oo = (size_t)t * 2048 + h * 128 + sub * 8;
          const u32x4 a0 = __builtin_nontemporal_load((const u32x4*)(op + oo)), a1 = __builtin_nontemporal_load((const u32x4*)(op + (size_t)T_TOK * 2048 + oo)), a2 = __builtin_nontemporal_load((const u32x4*)(op + (size_t)2 * T_TOK * 2048 + oo));
          const u32x4 gt = __builtin_nontemporal_load((const u32x4*)(proj + (size_t)t * NPROJ + 6144 + h * 128 + sub * 8));
          u32x4 o;
#define MIXW(F) { const float lo = (e0 * bflo(a0.F) + e1 * bflo(a1.F) + e2 * bflo(a2.F)) * silu_f(bflo(gt.F)), hi = (e0 * bfhi(a0.F) + e1 * bfhi(a1.F) + e2 * bfhi(a2.F)) * silu_f(bfhi(gt.F)); o.F = cvt_pk(lo, hi); }
          MIXW(x) MIXW(y) MIXW(z) MIXW(w)
#undef MIXW
          *(u32x4*)(mixed + (size_t)t * DMODEL + h * 128 + sub * 8) = o; }
        { const u32x4 ov = __builtin_nontemporal_load((const u32x4*)(Odn + (size_t)t * 2048 + h * 128 + sub * 8));
          float v[8] = {bflo(ov.x), bfhi(ov.x), bflo(ov.y), bfhi(ov.y), bflo(ov.z), bfhi(ov.z), bflo(ov.w), bfhi(ov.w)};
          float ss = 0.f;
#pragma unroll
          for (int e = 0; e < 8; ++e) ss += v[e] * v[e];
          ss += __shfl_xor(ss, 1); ss += __shfl_xor(ss, 2); ss += __shfl_xor(ss, 4); ss += __shfl_xor(ss, 8);
          const float rstd = rsqrtf(ss * (1.0f / 128.0f) + 1e-6f);
          const u32x4 gt = __builtin_nontemporal_load((const u32x4*)(proj + (size_t)t * NPROJ + 14336 + h * 128 + sub * 8));
          u32x4 o;
          o.x = cvt_pk(v[0] * rstd * g0[0] * silu_f(bflo(gt.x)), v[1] * rstd * g0[1] * silu_f(bfhi(gt.x)));
          o.y = cvt_pk(v[2] * rstd * g0[2] * silu_f(bflo(gt.y)), v[3] * rstd * g0[3] * silu_f(bfhi(gt.y)));
          o.z = cvt_pk(v[4] * rstd * g1[0] * silu_f(bflo(gt.z)), v[5] * rstd * g1[1] * silu_f(bfhi(gt.z)));
          o.w = cvt_pk(v[6] * rstd * g1[2] * silu_f(bflo(gt.w)), v[7] * rstd * g1[3] * silu_f(bfhi(gt.w)));
          *(u32x4*)(mixed + (size_t)t * DMODEL + 2048 + h * 128 + sub * 8) = o; }
    }
}

__device__ void phase_final_norm(const bf16_t* __restrict__ H, float* __restrict__ out, const float* __restrict__ g) {
    const int wid = threadIdx.x >> 6, lane = threadIdx.x & 63;
    const int gw = blockIdx.x * 8 + wid, nw = gridDim.x * 8;
    for (int row = gw; row < T_TOK; row += nw) {
        const u32x4* hr = (const u32x4*)(H + (size_t)row * DMODEL);
        f32x4* orow = (f32x4*)(out + (size_t)row * DMODEL);
        u32x4 v[8]; float ss = 0.f;
#pragma unroll
        for (int i = 0; i < 8; ++i) { v[i] = __builtin_nontemporal_load(hr + i * 64 + lane);
            ss += bflo(v[i].x) * bflo(v[i].x) + bfhi(v[i].x) * bfhi(v[i].x) + bflo(v[i].y) * bflo(v[i].y) + bfhi(v[i].y) * bfhi(v[i].y)
                + bflo(v[i].z) * bflo(v[i].z) + bfhi(v[i].z) * bfhi(v[i].z) + bflo(v[i].w) * bflo(v[i].w) + bfhi(v[i].w) * bfhi(v[i].w); }
        ss = wave_sum(ss);
        const float rstd = rsqrtf(ss * (1.0f / DMODEL) + 1e-6f);
#pragma unroll
        for (int i = 0; i < 8; ++i) { const int e = (i * 64 + lane) * 2; const f32x4 g0 = ((const f32x4*)g)[e], g1 = ((const f32x4*)g)[e + 1];
            __builtin_nontemporal_store((f32x4){bflo(v[i].x), bfhi(v[i].x), bflo(v[i].y), bfhi(v[i].y)} * rstd * g0, orow + e);
            __builtin_nontemporal_store((f32x4){bflo(v[i].z), bfhi(v[i].z), bflo(v[i].w), bfhi(v[i].w)} * rstd * g1, orow + e + 1); }
    }
}

__global__ void __launch_bounds__(512, 2) mega_fwd(Params p) {
    extern __shared__ __attribute__((aligned(16))) unsigned char shm[];
    LAS unsigned char* lds = (LAS unsigned char*)shm;
    cg::grid_group grid = cg::this_grid();
    unsigned char* ws = p.ws;
    bf16_t* xn = (bf16_t*)(ws + OFF_XN); bf16_t* WinT = (bf16_t*)(ws + OFF_WINT); bf16_t* WoutT = (bf16_t*)(ws + OFF_WOUTT); bf16_t* proj = (bf16_t*)(ws + OFF_PROJ);
    float* gate = (float*)(ws + OFF_GATE); bf16_t* mixed = (bf16_t*)(ws + OFF_MIXED); bf16_t* Ab = (bf16_t*)(ws + OFF_AB); float* lsep = (float*)(ws + OFF_LSE); float* Cd = (float*)(ws + OFF_CD);
    bf16_t* Wb = (bf16_t*)(ws + OFF_WB); bf16_t* Ub = (bf16_t*)(ws + OFF_UB); bf16_t* Qd = (bf16_t*)(ws + OFF_QD); bf16_t* Kt = (bf16_t*)(ws + OFF_KT);
    bf16_t* op = (bf16_t*)((unsigned char*)p.out + OUT_OP); bf16_t* Odn = (bf16_t*)((unsigned char*)p.out + OUT_ODN);
    const int G = (int)gridDim.x, c = (int)blockIdx.x;
    volatile LAS unsigned* xst = (volatile LAS unsigned*)(lds + 131072);
    if (threadIdx.x == 0) { xst[0] = 0u; xst[1] = 0u; }
    __syncthreads();
    XcdBarrier xb = xcd_barrier_post((unsigned*)(ws + WS_BAR), xst);

    if (p.mask & 1) for (int rep = 0; rep < REP_P0; ++rep) {
        phase_transpose(lds, p.w_out, DMODEL, DMODEL, DMODEL, WoutT);
        phase_transpose(lds, p.w_in, DMODEL, NIN, NIN, WinT);
        phase_rmsnorm_x(p.x, p.norm_g, xn);
    }
    if (p.coop == 2) grid.sync();
    if (p.coop) xcd_barrier(xb);
    if (p.mask & 2) {
        __syncthreads();
        for (int rb = c; rb < T_TOK / 64; rb += G) gate_gemm(lds, xn, WinT, gate, rb);
        pg8::Gemm g{xn, WinT, T_TOK, NPROJ, DMODEL}; RepOrder S; S.init(T_TOK, NPROJ, G, c); S.reps = REP_G1; EpiProj E{proj, gate};
        pg8::gemm_phase<EpiProj, RepOrder, false>(lds, g, S, E, nullptr);
        __syncthreads();
    }
    if (p.coop) xcd_barrier(xb);
    if (p.mask & 4) {
        { const int per = (N_ATTN_TASKS + G - 1) / G; for (int rep = 0; rep < REP_ATT; ++rep) attn_phase(lds, proj, op, lsep, c * per, (c + 1) * per < N_ATTN_TASKS ? (c + 1) * per : N_ATTN_TASKS); }
        for (int rep = 0; rep < REP_PREP; ++rep) { const int per = (4096 + G - 1) / G; int hprev = -1;
            const int ch0 = c * per, ch1 = (c + 1) * per < 4096 ? (c + 1) * per : 4096;
            PrepPre P;
            if (ch0 < ch1) dn_prep_prefetch(P, proj, gate, p.a_log, p.dt_bias, ch0);
            for (int chunk = ch0; chunk < ch1; ++chunk) { const int hh = (chunk >> 7) & 15;
                if (hh != hprev) { dn_stage_convw(lds, p.conv_w, hh); hprev = hh; }
                dn_prep_chunk(lds, proj, gate, p.a_log, p.dt_bias, Wb, Ub, Qd, Kt, Ab, Cd, chunk, chunk + 1 < ch1 ? chunk + 1 : -1, P); }
            __syncthreads(); }
    }
    if (p.coop) xcd_barrier(xb);
    if (p.mask & 8) {
        for (int rep = 0; rep < REP_SCAN; ++rep) for (int item = c; item < 256; item += G) dn_scan_item(lds, Wb, Ub, Qd, Kt, Ab, Cd, Odn, (bf16_t*)(ws + WS_END), item);
    }
    if (p.coop) xcd_barrier(xb);
    if (p.mask & 16) for (int rep = 0; rep < REP_FIN; ++rep) phase_finalize(proj, op, lsep, Odn, p.dn_norm_g, mixed);
    if (p.coop) xcd_barrier(xb);
    if (p.mask & 32) {
        __syncthreads();
        pg8::Gemm g{mixed, WoutT, T_TOK, DMODEL, DMODEL}; pg8::StaticOrder S; S.init(T_TOK, DMODEL, G, c); EpiResidBf E{proj  , p.x};
        pg8::gemm_phase<EpiResidBf, pg8::StaticOrder, false>(lds, g, S, E, nullptr);
        __syncthreads();
    }
    if (p.coop) xcd_barrier(xb);
    if (p.mask & 64) phase_final_norm(proj, p.out, p.final_g);
}

extern "C" void kernel_launch(void* const* d_in, const int* in_sizes, int n_in, void* d_out, int out_size, void* d_ws, size_t ws_size, hipStream_t stream) {
    static int grid = 0;
    if (grid == 0) {
        if (n_in != 9 || out_size != T_TOK * DMODEL || ws_size < WS_BAR + XCD_BAR_WORDS * 4) { fprintf(stderr, "kernel_launch: unexpected shapes (n_in %d out %d ws %zu)\n", n_in, out_size, ws_size); grid = -1; return; }
        int dev = 0, cus = 0, per_cu = 0;
        hipGetDevice(&dev); hipDeviceGetAttribute(&cus, hipDeviceAttributeMultiprocessorCount, dev);
        if (hipFuncSetAttribute((const void*)mega_fwd, hipFuncAttributeMaxDynamicSharedMemorySize, LDS_BYTES) != hipSuccess) { fprintf(stderr, "kernel_launch: hipFuncSetAttribute failed\n"); grid = -1; return; }
        if (hipOccupancyMaxActiveBlocksPerMultiprocessor(&per_cu, (const void*)mega_fwd, 512, LDS_BYTES) != hipSuccess || per_cu < 1) { fprintf(stderr, "kernel_launch: occupancy query gives %d\n", per_cu); per_cu = 1; }
        (void)hipGetLastError();
        grid = cus * 1;
    }
    if (grid < 0) return;
    if (hipMemsetAsync((char*)d_ws + WS_BAR, 0, XCD_BAR_WORDS * 4, stream) != hipSuccess) { fprintf(stderr, "kernel_launch: memset of barrier words failed\n"); return; }
    Params p{};
    p.x = (const float*)d_in[0]; p.norm_g = (const float*)d_in[1]; p.w_in = (const float*)d_in[2]; p.conv_w = (const float*)d_in[3]; p.a_log = (const float*)d_in[4];
    p.dt_bias = (const float*)d_in[5]; p.dn_norm_g = (const float*)d_in[6]; p.w_out = (const float*)d_in[7]; p.final_g = (const float*)d_in[8];
    p.out = (float*)d_out; p.ws = (unsigned char*)d_ws;
#if MK_COOP
    p.mask = 127; p.coop = 1;
    void* args[] = {&p};
    hipError_t e = hipLaunchCooperativeKernel((const void*)mega_fwd, dim3(grid), dim3(512), args, LDS_BYTES, stream);
    if (e != hipSuccess) fprintf(stderr, "cooperative launch failed: %s (grid %d)\n", hipGetErrorString(e), grid);
#else
    p.coop = 0;
    for (int ph = 0; ph < 7; ++ph) { p.mask = 1 << ph; hipLaunchKernelGGL(mega_fwd, dim3(grid), dim3(512), LDS_BYTES, stream, p); }
#endif
}
```

```cpp
#include <hip/hip_runtime.h>
#include <hip/hip_cooperative_groups.h>
#include <cstdio>
namespace cg = cooperative_groups;

#ifndef MK_COOP
#define MK_COOP 1
#endif

#ifndef REP_P0
#define REP_P0 1
#endif
#ifndef REP_G1
#define REP_G1 1
#endif
#ifndef REP_ATT
#define REP_ATT 1
#endif
#ifndef REP_PREP
#define REP_PREP 1
#endif
#ifndef REP_SCAN
#define REP_SCAN 1
#endif
#ifndef REP_FIN
#define REP_FIN 1
#endif
namespace pg8 {
#define PG8_LAS __attribute__((address_space(3)))
typedef unsigned short bf16_t;
typedef short bf16x8 __attribute__((ext_vector_type(8)));
typedef float f32x4 __attribute__((ext_vector_type(4)));
typedef unsigned u32x4 __attribute__((ext_vector_type(4)));
constexpr int BM = 256, BK = 64, HALF = 128, HTB = HALF * BK * 2  , STAGE_BYTES = 8 * HTB, NXCD = 8, WGM = 8;

__host__ __device__ __forceinline__ int lds_byte(int r, int c) { const int st = (r >> 4) * 2 + (c >> 5), rr = r & 15, cc = c & 31, ob = rr * 64 + cc * 2; return st * 1024 + (ob ^ (((ob >> 9) & 1) << 5)); }
__host__ __device__ __forceinline__ void stage_rc(int b, int& R, int& C) { const int st = b / 1024, sb = b % 1024, swz = sb ^ (((sb >> 9) & 1) << 5); R = (st >> 1) * 16 + swz / 64; C = (st & 1) * 32 + (swz % 64) / 2; }
__host__ __device__ __forceinline__ int perm32(int rho) { const int n = rho >> 4, i = rho & 15; return 8 * (i >> 2) + 4 * n + (i & 3); }

struct Unit { int pm, pn; };
struct Gemm { const bf16_t* A; const bf16_t* Bt; int M, N, K; };

struct StaticOrder {
    int nM, nN, nwg, G, c;
    __host__ __device__ void init(int M, int N, int G_, int c_) { nM = M / BM; nN = N / BM; nwg = nM * nN; G = G_; c = c_; }
    __host__ __device__ bool next(int i, Unit& u) const {
        const long L = (long)i * G + c; if (L >= nwg) return false;
        int wgid = (int)L; { const int q = nwg / NXCD, r = nwg % NXCD, xcd = wgid % NXCD, off = wgid / NXCD; wgid = (xcd < r ? xcd * (q + 1) : r * (q + 1) + (xcd - r) * q) + off; }
        const int nig = WGM * nN, gid = wgid / nig, fm = gid * WGM, gsz = (nM - fm) < WGM ? (nM - fm) : WGM;
        u.pm = fm + ((wgid % nig) % gsz); u.pn = (wgid % nig) / gsz; return true;
    }
    __device__ __forceinline__ void a_ready(const Unit&) const {}
    __device__ __forceinline__ void done(const Unit&) const {}
};
template <class Epi, class Sched, bool STAMP = false>
__device__ __forceinline__ void gemm_phase(PG8_LAS unsigned char* lds, const Gemm g, const Sched& S, const Epi& E, unsigned long long* stamps) {
    const int tid = threadIdx.x, wid = __builtin_amdgcn_readfirstlane(tid >> 6), lane = tid & 63, wr = wid >> 2, wc = wid & 3, fr = lane & 15, fq = lane >> 4;
    const int K = g.K, nt = K / BK;
    int ts_lo = 0, ts_hi = 0, nts = 0; const unsigned long long rt_entry = STAMP ? (unsigned long long)wall_clock64() : 0ull;
#define PG8_STAMP() do { if (STAMP && wid == 0 && nts < 64) { const unsigned long long _c = (unsigned long long)clock64(); \
        ts_lo = (lane == nts) ? (int)(unsigned)_c : ts_lo; ts_hi = (lane == nts) ? (int)(unsigned)(_c >> 32) : ts_hi; ++nts; } } while (0)
    PG8_STAMP();
    unsigned voffA[2], voffB[2];
#pragma unroll
    for (int i = 0; i < 2; ++i) { int R, C; stage_rc(tid * 16 + i * 8192, R, C); const int Rb = Epi::PERM ? ((R & ~31) + perm32(R & 31)) : R;
        voffA[i] = (unsigned)(R * K + C) * 2u; voffB[i] = (unsigned)(Rb * K + C) * 2u; }
    const size_t kstep = (size_t)(BK * 2);
    const size_t hstep = (size_t)HALF * K * 2;
    const size_t tstep = 2 * hstep;
    const unsigned ldsw = (unsigned)wid * 1024u;
    const int aoff = lds_byte(wr * 64 + fr, fq * 8), boff = lds_byte(wc * 32 + fr, fq * 8);
#define PG8_SA(b, h) (((b) * 2 + (h)) * HTB)
#define PG8_SB(b, h) ((4 + (b) * 2 + (h)) * HTB)
#define PG8_STAGE(bufoff, gbase, voff) do { _Pragma("unroll") for (int _i = 0; _i < 2; ++_i) \
        __builtin_amdgcn_global_load_lds((const unsigned*)((const char*)(gbase) + (voff)[_i]), (PG8_LAS unsigned*)(lds + (bufoff) + ldsw + _i * 8192), 16, 0, 0); } while (0)
#define PG8_LDA(dst, b, h) do { _Pragma("unroll") for (int m = 0; m < 4; ++m) _Pragma("unroll") for (int k = 0; k < 2; ++k) dst[m][k] = *(const PG8_LAS bf16x8*)(lds + PG8_SA(b, h) + aoff + m * 2048 + k * 1024); } while (0)
#define PG8_LDB(dst, b, h) do { _Pragma("unroll") for (int n = 0; n < 2; ++n) _Pragma("unroll") for (int k = 0; k < 2; ++k) dst[n][k] = *(const PG8_LAS bf16x8*)(lds + PG8_SB(b, h) + boff + n * 2048 + k * 1024); } while (0)
#define PG8_MMA(ai, bj, At, Bt) do { __builtin_amdgcn_s_setprio(1); _Pragma("unroll") for (int m = 0; m < 4; ++m) _Pragma("unroll") for (int n = 0; n < 2; ++n) _Pragma("unroll") for (int k = 0; k < 2; ++k) \
        acc[ai][bj][m][n] = __builtin_amdgcn_mfma_f32_16x16x32_bf16(Bt[n][k], At[m][k], acc[ai][bj][m][n], 0, 0, 0); __builtin_amdgcn_s_setprio(0); } while (0)
#define PG8_WAIT_V(n) asm volatile("s_waitcnt vmcnt(" #n ")" ::: "memory")
#define PG8_WAIT_L(n) asm volatile("s_waitcnt lgkmcnt(" #n ")" ::: "memory")
#define PG8_BAR __builtin_amdgcn_s_barrier()
#define PG8_SCHED __builtin_amdgcn_sched_barrier(0)
    Unit cur, nxt; int ui = 0;
    if (!S.next(0, cur)) return;
    f32x4 acc[2][2][4][2];
#pragma unroll
    for (int a = 0; a < 2; ++a)
#pragma unroll
        for (int b = 0; b < 2; ++b)
#pragma unroll
            for (int m = 0; m < 4; ++m)
#pragma unroll
                for (int n = 0; n < 2; ++n) acc[a][b][m][n] = (f32x4){0.f, 0.f, 0.f, 0.f};
    bf16x8 At[4][2], B0[2][2], B1[2][2];
    const char* cA = (const char*)g.A + (size_t)cur.pm * tstep; const char* cB = (const char*)g.Bt + (size_t)cur.pn * tstep;
    S.a_ready(cur);
    PG8_STAGE(PG8_SB(0, 0), cB, voffB); PG8_STAGE(PG8_SA(0, 0), cA, voffA); PG8_STAGE(PG8_SB(0, 1), cB + hstep, voffB); PG8_STAGE(PG8_SA(0, 1), cA + hstep, voffA);
    if (wr == 1) PG8_BAR;
    PG8_WAIT_V(4); PG8_BAR;
    PG8_STAGE(PG8_SB(1, 0), cB + kstep, voffB); PG8_STAGE(PG8_SA(1, 0), cA + kstep, voffA); PG8_STAGE(PG8_SB(1, 1), cB + hstep + kstep, voffB);
    PG8_WAIT_V(6); PG8_BAR;
    PG8_STAMP();
    for (;;) {
        const bool has_next = S.next(ui + 1, nxt);
        const char* nA = has_next ? (const char*)g.A + (size_t)nxt.pm * tstep : cA; const char* nB = has_next ? (const char*)g.Bt + (size_t)nxt.pn * tstep : cB;
        for (int t = 0; t < nt; t += 2) {
            const bool last = (t == nt - 2);
            const char* a1 = cA + (size_t)(t + 1) * kstep;
            const char* a2 = last ? nA : cA + (size_t)(t + 2) * kstep; const char* b2 = last ? nB : cB + (size_t)(t + 2) * kstep;
            const char* a3 = a2 + kstep; const char* b3 = b2 + kstep;
            if (last && has_next) S.a_ready(nxt);
            PG8_LDB(B0, 0, 0); PG8_SCHED; PG8_LDA(At, 0, 0); PG8_STAGE(PG8_SA(1, 1), a1 + hstep, voffA);
            PG8_WAIT_L(8); PG8_BAR; PG8_WAIT_L(0); PG8_MMA(0, 0, At, B0); PG8_BAR; PG8_SCHED;
            PG8_LDB(B1, 0, 1); PG8_STAGE(PG8_SB(0, 0), b2, voffB);
            PG8_BAR; PG8_WAIT_L(0); PG8_MMA(0, 1, At, B1); PG8_BAR;
            PG8_LDA(At, 0, 1); PG8_STAGE(PG8_SA(0, 0), a2, voffA);
            PG8_BAR; PG8_WAIT_L(0); PG8_MMA(1, 0, At, B0); PG8_BAR; PG8_SCHED;
            PG8_STAGE(PG8_SB(0, 1), b2 + hstep, voffB);
            PG8_WAIT_V(6); PG8_BAR; PG8_MMA(1, 1, At, B1); PG8_BAR;
            PG8_LDB(B0, 1, 0); PG8_SCHED; PG8_LDA(At, 1, 0); PG8_STAGE(PG8_SA(0, 1), a2 + hstep, voffA);
            PG8_WAIT_L(8); PG8_BAR; PG8_WAIT_L(0); PG8_MMA(0, 0, At, B0); PG8_BAR; PG8_SCHED;
            PG8_LDB(B1, 1, 1); PG8_STAGE(PG8_SB(1, 0), b3, voffB);
            PG8_BAR; PG8_WAIT_L(0); PG8_MMA(0, 1, At, B1); PG8_BAR;
            PG8_LDA(At, 1, 1); PG8_STAGE(PG8_SA(1, 0), a3, voffA);
            PG8_BAR; PG8_WAIT_L(0); PG8_MMA(1, 0, At, B0); PG8_BAR; PG8_SCHED;
            PG8_STAGE(PG8_SB(1, 1), b3 + hstep, voffB);
            PG8_WAIT_V(6); PG8_BAR; PG8_MMA(1, 1, At, B1); PG8_BAR;
        }
        PG8_STAMP();
        if constexpr (!Epi::AFTER_DRAIN) { E(acc, cur, wr, wc, fr, fq); S.done(cur); }
        PG8_STAMP();
        if (!has_next) break;
#pragma unroll
        for (int a = 0; a < 2; ++a)
#pragma unroll
            for (int b = 0; b < 2; ++b)
#pragma unroll
                for (int m = 0; m < 4; ++m)
#pragma unroll
                    for (int n = 0; n < 2; ++n) acc[a][b][m][n] = (f32x4){0.f, 0.f, 0.f, 0.f};
        cur = nxt; cA = nA; cB = nB; ++ui;
    }
    PG8_WAIT_V(0);
    if (wr == 0) PG8_BAR;
    PG8_BAR;
    if constexpr (Epi::AFTER_DRAIN) { E.fused(acc, cur, wr, wc, fr, fq, lds, wid, lane); S.done(cur); }
    PG8_STAMP();
    if (STAMP && wid == 0) { stamps[lane] = lane < nts ? (((unsigned long long)(unsigned)ts_hi << 32) | (unsigned)ts_lo) : 0ull;
        if (lane == 62) stamps[62] = rt_entry; if (lane == 63) stamps[63] = (unsigned long long)wall_clock64(); }
#undef PG8_STAMP
#undef PG8_SA
#undef PG8_SB
#undef PG8_STAGE
#undef PG8_LDA
#undef PG8_LDB
#undef PG8_MMA
#undef PG8_WAIT_V
#undef PG8_WAIT_L
#undef PG8_BAR
#undef PG8_SCHED
}
}

#define LAS __attribute__((address_space(3)))
#define XB_TMO      128
#define XB_XCNT(j)  (256  + 64 * (j))
#define XB_XSUB(j)  (1280 + 64 * (j))
#define XB_XGEN(j)  (2304 + 64 * (j))
#define XB_TOP      3328
#define XB_TOPGEN   3392
#define XCD_BAR_WORDS 3456
#define XB_SPIN_CAP (1u << 18)

__device__ __forceinline__ unsigned xb_ld(unsigned* p)              { return __hip_atomic_load(p, __ATOMIC_RELAXED, __HIP_MEMORY_SCOPE_AGENT); }
__device__ __forceinline__ unsigned xb_add(unsigned* p, unsigned v) { return __hip_atomic_fetch_add(p, v, __ATOMIC_RELAXED, __HIP_MEMORY_SCOPE_AGENT); }
__device__ __forceinline__ unsigned xb_xcc_id() { return (unsigned)__builtin_amdgcn_s_getreg((3 << 11) | 20) & 0xFu; }
#define XB_SPIN(cond, bar) do { unsigned _sp = 0; while (cond) { __builtin_amdgcn_s_sleep(1); \
    if ((++_sp & 255u) == 0u) { if (xb_ld(&(bar)[XB_TMO])) break; if (_sp > XB_SPIN_CAP) { atomicAdd(&(bar)[XB_TMO], 1u); break; } } } } while (0)

struct XcdBarrier {
    unsigned* bar; unsigned x;
    volatile LAS unsigned* st;
};

__device__ __forceinline__ XcdBarrier xcd_barrier_post(unsigned* bar, volatile LAS unsigned* st) {
    XcdBarrier b; b.bar = bar; b.x = xb_xcc_id(); b.st = st;
    if (threadIdx.x == 0) (void)xb_add(&bar[XB_XCNT(b.x)], 1u);
    return b;
}
__device__ __forceinline__ void xcd_barrier_complete(unsigned* bar, unsigned x, unsigned& nloc, unsigned& nx) {
    const unsigned G = gridDim.x * gridDim.y * gridDim.z;
    unsigned sum, cnt, mine, sp = 0u;
    for (;;) {
        sum = 0u; cnt = 0u; mine = 0u;
#pragma unroll
        for (unsigned j = 0; j < 16; ++j) { const unsigned c = xb_ld(&bar[XB_XCNT(j)]); sum += c; cnt += (c > 0u) ? 1u : 0u; mine = (j == x) ? c : mine; }
        if (sum == G) break;
        __builtin_amdgcn_s_sleep(1);
        if ((++sp & 255u) == 0u) { if (xb_ld(&bar[XB_TMO])) break; if (sp > XB_SPIN_CAP) { atomicAdd(&bar[XB_TMO], 1u); break; } }
    }
    nloc = mine > 0u ? mine : 1u; nx = cnt > 0u ? cnt : 1u;
}

__device__ __forceinline__ void xcd_barrier(const XcdBarrier& b) {
    asm volatile("s_waitcnt vmcnt(0)" ::: "memory");
    __syncthreads();
    if (threadIdx.x == 0) {
        unsigned* bar = b.bar;
        __builtin_amdgcn_s_waitcnt(0);
        unsigned nloc = b.st[0], nx = b.st[1];
        if (nloc == 0u) { xcd_barrier_complete(bar, b.x, nloc, nx); b.st[0] = nloc; b.st[1] = nx; }
        const unsigned old = xb_add(&bar[XB_XSUB(b.x)], 1u);
        const unsigned gen = old / nloc;
        if (old + 1u == (gen + 1u) * nloc) {
            __builtin_amdgcn_fence(__ATOMIC_RELEASE, "agent");
            asm volatile("s_waitcnt vmcnt(0)" ::: "memory");
            const unsigned og = xb_add(&bar[XB_TOP], 1u);
            const unsigned tg = og / nx;
            if (og + 1u == (tg + 1u) * nx) xb_add(&bar[XB_TOPGEN], 1u);
            else XB_SPIN(xb_ld(&bar[XB_TOPGEN]) == tg, bar);
            __builtin_amdgcn_fence(__ATOMIC_ACQUIRE, "agent");
            xb_add(&bar[XB_XGEN(b.x)], 1u);
            asm volatile("s_waitcnt vmcnt(0)" ::: "memory");
        } else {
            XB_SPIN(xb_ld(&bar[XB_XGEN(b.x)]) == gen, bar);
            __builtin_amdgcn_fence(__ATOMIC_ACQUIRE, "agent");
            asm volatile("s_waitcnt vmcnt(0)" ::: "memory");
        }
    }
    __syncthreads();
}


typedef unsigned short bf16_t;
typedef short bf16x8 __attribute__((ext_vector_type(8)));
typedef short bf16x4 __attribute__((ext_vector_type(4)));
typedef float f32x4 __attribute__((ext_vector_type(4)));
typedef unsigned u32x4 __attribute__((ext_vector_type(4)));
typedef unsigned u32x2 __attribute__((ext_vector_type(2)));

constexpr int T_TOK = 16384, DMODEL = 4096, SEQ = 8192, NPROJ = 16384, NIN = 16416, NPAD = 16640;
constexpr int LDS_BYTES = 131072 + 16;
constexpr size_t OFF_XN = 0, OFF_WINT = 134217728ull, OFF_WOUTT = 270532608ull, OFF_PROJ = 304087040ull, OFF_GATE = 840957952ull,
                 OFF_MIXED = 843055104ull, OFF_AB = 977272832ull, OFF_LSE = 1010827264ull, OFF_CD = 1013972992ull, WS_END = 1013989376ull, WS_BAR = WS_END + (8ull << 20);
constexpr size_t OFF_WB = 0, OFF_UB = 67108864ull, OFF_QD = 134217728ull, OFF_KT = 201326592ull;
constexpr size_t OUT_OP = 0, OUT_ODN = 201326592ull;

struct Params {
    const float* x; const float* norm_g; const float* w_in; const float* conv_w; const float* a_log; const float* dt_bias; const float* dn_norm_g; const float* w_out; const float* final_g;
    float* out; unsigned char* ws; int mask; int coop;
};

typedef __bf16 bf16v2_t __attribute__((ext_vector_type(2)));
typedef float f32v2_t __attribute__((ext_vector_type(2)));
__device__ __forceinline__ unsigned cvt_pk(float lo, float hi) { f32v2_t v = {lo, hi}; bf16v2_t b = __builtin_convertvector(v, bf16v2_t); return __builtin_bit_cast(unsigned, b); }
__device__ __forceinline__ float bflo(unsigned w) { return __uint_as_float(w << 16); }
__device__ __forceinline__ float bfhi(unsigned w) { return __uint_as_float(w & 0xffff0000u); }
__device__ __forceinline__ float bf2f(bf16_t v) { return __uint_as_float(((unsigned)v) << 16); }
__device__ __forceinline__ bf16_t f2bf(float f) { return (bf16_t)(cvt_pk(f, 0.f) & 0xffffu); }
__device__ __forceinline__ float silu_f(float v) { return v / (1.0f + __expf(-v)); }
__device__ __forceinline__ f32x4 mfma32(bf16x8 a, bf16x8 b, f32x4 c) { return __builtin_amdgcn_mfma_f32_16x16x32_bf16(a, b, c, 0, 0, 0); }
__device__ __forceinline__ f32x4 mfma16(bf16x4 a, bf16x4 b, f32x4 c) { return __builtin_amdgcn_mfma_f32_16x16x16bf16_1k(a, b, c, 0, 0, 0); }

struct EpiProj {
    static constexpr bool PERM = true, AFTER_DRAIN = false;
    bf16_t* O; float* gate;
    __device__ __forceinline__ void operator()(const f32x4 (&acc)[2][2][4][2], const pg8::Unit& u, int wr, int wc, int fr, int fq) const {
        const int row0 = u.pm * 256 + wr * 64 + fr;
        if (u.pn < 64) {
            const int col0 = u.pn * 256 + wc * 32 + 8 * fq;
#pragma unroll
            for (int ai = 0; ai < 2; ++ai)
#pragma unroll
                for (int m = 0; m < 4; ++m) { bf16_t* rowp = O + (size_t)(row0 + ai * 128 + m * 16) * NPROJ + col0;
#pragma unroll
                    for (int bj = 0; bj < 2; ++bj) { const f32x4 v0 = acc[ai][bj][m][0], v1 = acc[ai][bj][m][1];
                        u32x4 w; w.x = cvt_pk(v0[0], v0[1]); w.y = cvt_pk(v0[2], v0[3]); w.z = cvt_pk(v1[0], v1[1]); w.w = cvt_pk(v1[2], v1[3]);
                        *(u32x4*)(rowp + bj * 128) = w; } }
        } else if (wc == 0) {
#pragma unroll
            for (int ai = 0; ai < 2; ++ai)
#pragma unroll
                for (int m = 0; m < 4; ++m) { float* gp = gate + (size_t)(row0 + ai * 128 + m * 16) * 32 + 8 * fq;
                    *(f32x4*)gp = acc[ai][0][m][0]; *(f32x4*)(gp + 4) = acc[ai][0][m][1]; }
        }
    }
};
struct EpiResid {
    static constexpr bool PERM = false, AFTER_DRAIN = false;
    float* C; const float* X;
    __device__ __forceinline__ void operator()(const f32x4 (&acc)[2][2][4][2], const pg8::Unit& u, int wr, int wc, int fr, int fq) const {
        const int row0 = u.pm * 256 + wr * 64 + fr, col0 = u.pn * 256 + wc * 32 + 4 * fq;
#pragma unroll
        for (int ai = 0; ai < 2; ++ai)
#pragma unroll
            for (int m = 0; m < 4; ++m) { const size_t off = (size_t)(row0 + ai * 128 + m * 16) * DMODEL + col0;
#pragma unroll
                for (int bj = 0; bj < 2; ++bj)
#pragma unroll
                    for (int n = 0; n < 2; ++n) { const f32x4 xv = *(const f32x4*)(X + off + bj * 128 + n * 16); *(f32x4*)(C + off + bj * 128 + n * 16) = acc[ai][bj][m][n] + xv; } }
    }
};

struct EpiResidBf {
    static constexpr bool PERM = true, AFTER_DRAIN = false;
    bf16_t* H; const float* X;
    __device__ __forceinline__ void operator()(const f32x4 (&acc)[2][2][4][2], const pg8::Unit& u, int wr, int wc, int fr, int fq) const {
        const int row0 = u.pm * 256 + wr * 64 + fr, col0 = u.pn * 256 + wc * 32 + 8 * fq;
#pragma unroll
        for (int ai = 0; ai < 2; ++ai)
#pragma unroll
            for (int m = 0; m < 4; ++m) { const size_t off = (size_t)(row0 + ai * 128 + m * 16) * DMODEL + col0;
#pragma unroll
                for (int bj = 0; bj < 2; ++bj) { const f32x4 x0 = __builtin_nontemporal_load((const f32x4*)(X + off + bj * 128)), x1 = __builtin_nontemporal_load((const f32x4*)(X + off + bj * 128 + 4));
                    const f32x4 v0 = acc[ai][bj][m][0] + x0, v1 = acc[ai][bj][m][1] + x1;
                    u32x4 w; w.x = cvt_pk(v0[0], v0[1]); w.y = cvt_pk(v0[2], v0[3]); w.z = cvt_pk(v1[0], v1[1]); w.w = cvt_pk(v1[2], v1[3]);
                    *(u32x4*)(H + off + bj * 128) = w; } }
    }
};
struct RepOrder : pg8::StaticOrder {
    int reps;
    __device__ bool next(int i, pg8::Unit& u) const {
        const long L = (long)i * G + c; if (L >= (long)nwg * reps) return false;
        int wgid = (int)(L % nwg); { const int q = nwg / pg8::NXCD, r = nwg % pg8::NXCD, xcd = wgid % pg8::NXCD, off = wgid / pg8::NXCD; wgid = (xcd < r ? xcd * (q + 1) : r * (q + 1) + (xcd - r) * q) + off; }
        const int nig = pg8::WGM * nN, gid = wgid / nig, fm = gid * pg8::WGM, gsz = (nM - fm) < pg8::WGM ? (nM - fm) : pg8::WGM;
        u.pm = fm + ((wgid % nig) % gsz); u.pn = nN - 1 - (wgid % nig) / gsz; return true;
    }
};
__device__ __forceinline__ float wave_sum(float v) {
#pragma unroll
    for (int o = 32; o >= 1; o >>= 1) v += __shfl_xor(v, o);
    return v;
}
__device__ void phase_rmsnorm_x(const float* __restrict__ x, const float* __restrict__ g, bf16_t* __restrict__ xn) {
    const int wid = threadIdx.x >> 6, lane = threadIdx.x & 63;
    const int gw = blockIdx.x * 8 + wid, nw = gridDim.x * 8;
    for (int row = gw; row < T_TOK; row += nw) {
        const f32x4* xr = (const f32x4*)(x + (size_t)row * DMODEL);
        f32x4 v[16]; float ss = 0.f;
#pragma unroll
        for (int i = 0; i < 16; ++i) { v[i] = __builtin_nontemporal_load(xr + i * 64 + lane); ss += v[i][0] * v[i][0] + v[i][1] * v[i][1] + v[i][2] * v[i][2] + v[i][3] * v[i][3]; }
        ss = wave_sum(ss);
        const float rstd = rsqrtf(ss * (1.0f / DMODEL) + 1e-6f);
        bf16_t* orow = xn + (size_t)row * DMODEL;
#pragma unroll
        for (int i = 0; i < 16; ++i) { const f32x4 gg = ((const f32x4*)g)[i * 64 + lane]; u32x2 w; w.x = cvt_pk(v[i][0] * rstd * gg[0], v[i][1] * rstd * gg[1]); w.y = cvt_pk(v[i][2] * rstd * gg[2], v[i][3] * rstd * gg[3]);
            *(u32x2*)(orow + (i * 64 + lane) * 4) = w; }
    }
}
__device__ void phase_transpose(LAS unsigned char* lds, const float* __restrict__ W, int K, int N, int Npad, bf16_t* __restrict__ Wt) {
    const int wid = threadIdx.x >> 6, lane = threadIdx.x & 63;
    const int gw = blockIdx.x * 8 + wid, nw = gridDim.x * 8;
    const int nkt = K / 64, total = nkt * (Npad / 32);
    LAS bf16_t* tl = (LAS bf16_t*)(lds + wid * 4352);
    const int c4 = lane & 7, kr = lane >> 3, rn = lane >> 1, half = lane & 1;
    for (int tile = gw; tile < total; tile += nw) {
        const int nnt = Npad / 32, kt = tile / nnt, nt = tile - kt * nnt, n0 = nt * 32, k0 = kt * 64;
        const int n = n0 + 4 * c4;
#pragma unroll
        for (int it = 0; it < 8; ++it) { const int k = it * 8 + kr;
            f32x4 v = (f32x4){0.f, 0.f, 0.f, 0.f};
            if (n < N) v = __builtin_nontemporal_load((const f32x4*)(W + (size_t)(k0 + k) * N + n));
            const unsigned p0 = cvt_pk(v[0], v[1]), p1 = cvt_pk(v[2], v[3]);
            tl[(4 * c4 + 0) * 66 + k] = (bf16_t)(p0 & 0xffffu); tl[(4 * c4 + 1) * 66 + k] = (bf16_t)(p0 >> 16);
            tl[(4 * c4 + 2) * 66 + k] = (bf16_t)(p1 & 0xffffu); tl[(4 * c4 + 3) * 66 + k] = (bf16_t)(p1 >> 16); }
        asm volatile("s_waitcnt lgkmcnt(0)" ::: "memory");
        __builtin_amdgcn_wave_barrier();
        const LAS unsigned* rp = (const LAS unsigned*)(tl + rn * 66 + 32 * half);
        unsigned d[16];
#pragma unroll
        for (int i = 0; i < 16; ++i) d[i] = rp[i];
        bf16_t* op = Wt + (size_t)(n0 + rn) * K + k0 + 32 * half;
#pragma unroll
        for (int i = 0; i < 4; ++i) *(u32x4*)(op + 8 * i) = (u32x4){d[4 * i], d[4 * i + 1], d[4 * i + 2], d[4 * i + 3]};
        asm volatile("s_waitcnt lgkmcnt(0)" ::: "memory");
        __builtin_amdgcn_wave_barrier();
    }
}

__device__ __forceinline__ void gate_gemm(LAS unsigned char* lds, const bf16_t* __restrict__ xn, const bf16_t* __restrict__ WinT, float* __restrict__ gate, int rb) {
    const int tid = threadIdx.x, wid = tid >> 6, lane = tid & 63, fr = lane & 15, g = lane >> 4;
    f32x4 acc[4][2];
#pragma unroll
    for (int mt = 0; mt < 4; ++mt) { acc[mt][0] = (f32x4){0.f, 0.f, 0.f, 0.f}; acc[mt][1] = (f32x4){0.f, 0.f, 0.f, 0.f}; }
    const bf16_t* arow = xn + (size_t)(rb * 64 + fr) * DMODEL + wid * 512 + 8 * g;
    const bf16_t* brow = WinT + (size_t)(NPROJ + fr) * DMODEL + wid * 512 + 8 * g;
#pragma unroll 4
    for (int ks = 0; ks < 16; ++ks) {
        bf16x8 a[4], b[2];
#pragma unroll
        for (int mt = 0; mt < 4; ++mt) a[mt] = *(const bf16x8*)(arow + (size_t)(16 * mt) * DMODEL + 32 * ks);
#pragma unroll
        for (int nt = 0; nt < 2; ++nt) b[nt] = *(const bf16x8*)(brow + (size_t)(16 * nt) * DMODEL + 32 * ks);
#pragma unroll
        for (int mt = 0; mt < 4; ++mt)
#pragma unroll
            for (int nt = 0; nt < 2; ++nt) acc[mt][nt] = mfma32(a[mt], b[nt], acc[mt][nt]);
    }
    LAS float* red = (LAS float*)lds;
#pragma unroll
    for (int mt = 0; mt < 4; ++mt)
#pragma unroll
        for (int nt = 0; nt < 2; ++nt)
#pragma unroll
            for (int reg = 0; reg < 4; ++reg) red[(wid * 64 + 16 * mt + 4 * g + reg) * 32 + 16 * nt + fr] = acc[mt][nt][reg];
    __syncthreads();
#pragma unroll
    for (int i = 0; i < 4; ++i) { const int e = tid + 512 * i; float s = 0.f;
#pragma unroll
        for (int w = 0; w < 8; ++w) s += red[w * 2048 + e];
        gate[(size_t)(rb * 64) * 32 + e] = s; }
    __syncthreads();
}

constexpr int N_ATTN_TASKS = 3 * 2 * 16 * 64;
#define LDS_BARRIER() do { asm volatile("s_waitcnt lgkmcnt(0)" ::: "memory"); __builtin_amdgcn_s_barrier(); asm volatile("" ::: "memory"); } while (0)
struct AttnPre { u32x4 k[8], v[8]; bf16x8 q[4]; };
struct AttnTask { int p, b, h, n, dil, tb; };
__device__ __forceinline__ AttnTask attn_decode(int task) {
    AttnTask t; t.p = task >> 11; const int rem = task & 2047; t.b = rem >> 10; t.h = (rem >> 6) & 15; const int idx = rem & 63;
    const int dsh = 2 * t.p, nbp = 64 >> dsh; t.dil = 1 << dsh; const int r = idx >> (6 - dsh); t.n = idx & (nbp - 1); t.tb = t.b * SEQ + r; return t;
}
__device__ __forceinline__ void attn_prefetch(AttnPre& P, const bf16_t* __restrict__ proj, int task, bool cont, int tid) {
    const AttnTask t = attn_decode(task);
    const int jb = cont ? 128 : 0;
#pragma unroll
    for (int i = 0; i < 4; ++i) {
        const int c = tid + 512 * i, j = jb + (c >> 4), ch = c & 15, idxk = (t.n - 1) * 128 + j;
        const bf16_t* rowp = proj + (size_t)(t.tb + (idxk < 0 ? 0 : idxk) * t.dil) * NPROJ + t.h * 128 + ch * 8;
        P.k[i] = *(const u32x4*)(rowp + 2048); P.v[i] = *(const u32x4*)(rowp + 4096);
    }
    if (!cont) {
#pragma unroll
        for (int i = 4; i < 8; ++i) {
            const int c = tid + 512 * i, j = c >> 4, ch = c & 15, idxk = (t.n - 1) * 128 + j;
            const bf16_t* rowp = proj + (size_t)(t.tb + (idxk < 0 ? 0 : idxk) * t.dil) * NPROJ + t.h * 128 + ch * 8;
            P.k[i] = *(const u32x4*)(rowp + 2048); P.v[i] = *(const u32x4*)(rowp + 4096);
        }
    }
    { const int wid = tid >> 6, lane = tid & 63, fr = lane & 15, g = lane >> 4;
      const bf16_t* qrow = proj + (size_t)(t.tb + (t.n * 128 + 16 * wid + fr) * t.dil) * NPROJ + t.h * 128;
#pragma unroll
      for (int s = 0; s < 4; ++s) P.q[s] = *(const bf16x8*)(qrow + 32 * s + 8 * g); }
}
__device__ __forceinline__ void attn_compute(LAS unsigned char* lds, const bf16_t* __restrict__ proj, bf16_t* __restrict__ op, float* __restrict__ lsep, int task, int next_task, bool cont, bool next_cont, int par, AttnPre& P) {
    const int tid = threadIdx.x, wid = tid >> 6, lane = tid & 63, fr = lane & 15, g = lane >> 4;
    const AttnTask t = attn_decode(task);
    const int p = t.p, h = t.h, n = t.n, dil = t.dil, px = par << 7;
    const float slope = exp2f(-0.5f * (float)(h + 1));
    { const int jb = cont ? 128 : 0;
#pragma unroll
      for (int i = 0; i < 4; ++i) {
          const int c = tid + 512 * i, j = jb + (c >> 4), ch = c & 15, idxk = (n - 1) * 128 + j, jp = j ^ px;
          u32x4 kv = P.k[i], vv = P.v[i];
          if (idxk < 0) { kv = (u32x4){0u, 0u, 0u, 0u}; vv = (u32x4){0u, 0u, 0u, 0u}; }
          *(LAS u32x4*)(lds + jp * 256 + ((ch ^ (j & 15)) << 4)) = kv;
          *(LAS u32x4*)(lds + 65536 + jp * 256 + ((ch ^ ((j & 7) << 1)) << 4)) = vv;
      }
      if (!cont) {
#pragma unroll
          for (int i = 4; i < 8; ++i) {
              const int c = tid + 512 * i, j = c >> 4, ch = c & 15, idxk = (n - 1) * 128 + j, jp = j ^ px;
              u32x4 kv = P.k[i], vv = P.v[i];
              if (idxk < 0) { kv = (u32x4){0u, 0u, 0u, 0u}; vv = (u32x4){0u, 0u, 0u, 0u}; }
              *(LAS u32x4*)(lds + jp * 256 + ((ch ^ (j & 15)) << 4)) = kv;
              *(LAS u32x4*)(lds + 65536 + jp * 256 + ((ch ^ ((j & 7) << 1)) << 4)) = vv;
          }
      } }
    const int tq = t.tb + (n * 128 + 16 * wid + fr) * dil;
    bf16x8 qf[4];
#pragma unroll
    for (int s = 0; s < 4; ++s) qf[s] = P.q[s];
    LDS_BARRIER();
    if (next_task >= 0) attn_prefetch(P, proj, next_task, next_cont, tid);
    float sc[9][4];
    float mx = -1e30f;
#pragma unroll
    for (int kt9 = 0; kt9 < 9; ++kt9) {
        const int kt = wid + kt9, jr = (16 * kt) ^ px;
        f32x4 acc = (f32x4){0.f, 0.f, 0.f, 0.f};
#pragma unroll
        for (int s = 0; s < 4; ++s) { const bf16x8 kf = *(const LAS bf16x8*)(lds + (jr + fr) * 256 + (((4 * s + g) ^ fr) << 4)); acc = mfma32(kf, qf[s], acc); }
#pragma unroll
        for (int reg = 0; reg < 4; ++reg) { const int j = 16 * kt + 4 * g + reg, l = 16 * wid + fr, dist = l + 128 - j;
            const bool valid = (dist >= 0) && (dist <= 128) && (n > 0 || j >= 128);
            const float v = valid ? acc[reg] * 0.08838834764831845f - slope * (float)(dist * dil) : -1e30f;
            sc[kt9][reg] = v; mx = fmaxf(mx, v); }
    }
    mx = fmaxf(mx, __shfl_xor(mx, 16)); mx = fmaxf(mx, __shfl_xor(mx, 32));
    float sum = 0.f;
    bf16x4 pk[9];
#pragma unroll
    for (int kt9 = 0; kt9 < 9; ++kt9) {
        float e[4];
#pragma unroll
        for (int reg = 0; reg < 4; ++reg) { e[reg] = __expf(sc[kt9][reg] - mx); sum += e[reg]; }
        u32x2 w; w.x = cvt_pk(e[0], e[1]); w.y = cvt_pk(e[2], e[3]);
        pk[kt9] = __builtin_bit_cast(bf16x4, w);
    }
    sum += __shfl_xor(sum, 16); sum += __shfl_xor(sum, 32);
    const float inv = 1.0f / sum, lse = mx + __logf(sum);
    bf16_t* orow = op + ((size_t)p * T_TOK + tq) * 2048 + h * 128;
    const int tq4 = fr >> 2, tp4 = fr & 3, krow = 4 * g + tq4;
    const unsigned vbase = (unsigned)(size_t)lds + 65536u + (unsigned)(krow * 256 + 8 * (tp4 & 1));
    unsigned rt[9];
#pragma unroll
    for (int kt9 = 0; kt9 < 9; ++kt9) rt[kt9] = (unsigned)(((16 * (wid + kt9)) ^ px) * 256);
#pragma unroll
    for (int dt = 0; dt < 8; ++dt) {
        f32x4 acc = (f32x4){0.f, 0.f, 0.f, 0.f};
        const unsigned va = vbase + (unsigned)((((2 * dt + (tp4 >> 1)) ^ ((krow & 7) << 1))) << 4);
        unsigned ad[9];
#pragma unroll
        for (int kt9 = 0; kt9 < 9; ++kt9) ad[kt9] = va + rt[kt9];
        u32x2 vt[9];
        asm volatile("ds_read_b64_tr_b16 %0, %9\n\tds_read_b64_tr_b16 %1, %10\n\tds_read_b64_tr_b16 %2, %11\n\tds_read_b64_tr_b16 %3, %12\n\t"
                     "ds_read_b64_tr_b16 %4, %13\n\tds_read_b64_tr_b16 %5, %14\n\tds_read_b64_tr_b16 %6, %15\n\tds_read_b64_tr_b16 %7, %16\n\t"
                     "ds_read_b64_tr_b16 %8, %17\n\ts_waitcnt lgkmcnt(0)"
                     : "=&v"(vt[0]), "=&v"(vt[1]), "=&v"(vt[2]), "=&v"(vt[3]), "=&v"(vt[4]), "=&v"(vt[5]), "=&v"(vt[6]), "=&v"(vt[7]), "=&v"(vt[8])
                     : "v"(ad[0]), "v"(ad[1]), "v"(ad[2]), "v"(ad[3]), "v"(ad[4]), "v"(ad[5]), "v"(ad[6]), "v"(ad[7]), "v"(ad[8]) : "memory");
#pragma unroll
        for (int kt9 = 0; kt9 < 9; ++kt9) acc = mfma16(__builtin_bit_cast(bf16x4, vt[kt9]), pk[kt9], acc);
        u32x2 w; w.x = cvt_pk(acc[0] * inv, acc[1] * inv); w.y = cvt_pk(acc[2] * inv, acc[3] * inv);
        *(u32x2*)(orow + 16 * dt + 4 * g) = w;
    }
    if (g == 0) lsep[((size_t)p * T_TOK + tq) * 16 + h] = lse;
    LDS_BARRIER();
}
__device__ __forceinline__ void attn_phase(LAS unsigned char* lds, const bf16_t* __restrict__ proj, bf16_t* __restrict__ op, float* __restrict__ lsep, int t0, int t1) {
    const int tid = threadIdx.x;
    if (t0 >= t1) return;
    AttnPre P;
    attn_prefetch(P, proj, t0, false, tid);
    int par = 0; bool cont = false;
    for (int task = t0; task < t1; ++task) {
        const int nxt = task + 1 < t1 ? task + 1 : -1;
        const bool next_cont = nxt >= 0 && attn_decode(nxt).n > 0;
        attn_compute(lds, proj, op, lsep, task, nxt, cont, next_cont, par, P);
        cont = next_cont; par = next_cont ? (par ^ 1) : 0;
    }
    __syncthreads();
}

constexpr int DN_Q = 0, DN_K = 17408, DN_V = 34816, DN_AD = 52224, DN_ABF = 56320, DN_TBF = 65536, DN_GC = 68608, DN_BETA = 68864, DN_EG = 69120, DN_CW = 69376;
__device__ void dn_stage_convw(LAS unsigned char* lds, const float* __restrict__ conv_w, int h) {
    LAS float* cw_s = (LAS float*)(lds + DN_CW);
    for (int e = threadIdx.x; e < 1536; e += 512) { const int j = e / 384, r = e - j * 384, X = r >> 7, col = r & 127; cw_s[e] = conv_w[j * 6144 + X * 2048 + h * 128 + col]; }
    __syncthreads();
}
template <int X> __device__ __forceinline__ void dn_conv_block(LAS unsigned char* lds, const LAS float* cw_s, const u32x4 (&xin)[2][4], int s0, int i, int cg8) {
    float y[16];
#pragma unroll
    for (int hf = 0; hf < 2; ++hf) {
        float acc[8];
#pragma unroll
        for (int e = 0; e < 8; ++e) acc[e] = 0.f;
#pragma unroll
        for (int j = 0; j < 4; ++j) { const int sp = s0 + i - 3 + j; const float mj = sp >= 0 ? 1.0f : 0.0f;
            const u32x4 xv = xin[hf][j];
            const f32x4 w0 = *(const LAS f32x4*)(cw_s + j * 384 + X * 128 + 16 * cg8 + 8 * hf) * mj, w1 = *(const LAS f32x4*)(cw_s + j * 384 + X * 128 + 16 * cg8 + 8 * hf + 4) * mj;
            acc[0] += w0[0] * bflo(xv.x); acc[1] += w0[1] * bfhi(xv.x); acc[2] += w0[2] * bflo(xv.y); acc[3] += w0[3] * bfhi(xv.y);
            acc[4] += w1[0] * bflo(xv.z); acc[5] += w1[1] * bfhi(xv.z); acc[6] += w1[2] * bflo(xv.w); acc[7] += w1[3] * bfhi(xv.w); }
#pragma unroll
        for (int e = 0; e < 8; ++e) y[hf * 8 + e] = silu_f(acc[e]);
        asm volatile("" ::: "memory");
    }
    if (X < 2) { float ss = 0.f;
#pragma unroll
        for (int e = 0; e < 16; ++e) ss += y[e] * y[e];
        ss += __shfl_xor(ss, 1); ss += __shfl_xor(ss, 2); ss += __shfl_xor(ss, 4);
        const float scl = rsqrtf(ss + 1e-6f) * (X == 0 ? 0.08838834764831845f : 1.0f);
#pragma unroll
        for (int e = 0; e < 16; ++e) y[e] *= scl; }
    LAS u32x4* dst = (LAS u32x4*)(lds + X * 17408 + i * 272 + cg8 * 32);
    dst[0] = (u32x4){cvt_pk(y[0], y[1]), cvt_pk(y[2], y[3]), cvt_pk(y[4], y[5]), cvt_pk(y[6], y[7])};
    dst[1] = (u32x4){cvt_pk(y[8], y[9]), cvt_pk(y[10], y[11]), cvt_pk(y[12], y[13]), cvt_pk(y[14], y[15])};
}
struct PrepPre { u32x4 x[2][2][4]; float bl, al, alog, dtb; };
__device__ __forceinline__ void dn_prep_prefetch(PrepPre& P, const bf16_t* __restrict__ proj, const float* __restrict__ gate, const float* __restrict__ a_log, const float* __restrict__ dt_bias, int chunk) {
    const int tid = threadIdx.x, wid = tid >> 6, lane = tid & 63;
    const int bh = chunk >> 7, n = chunk & 127, b = bh >> 4, h = bh & 15, s0 = n * 64, i = tid >> 3, cg8 = tid & 7;
#pragma unroll
    for (int X = 0; X < 2; ++X)
#pragma unroll
        for (int hf = 0; hf < 2; ++hf)
#pragma unroll
            for (int j = 0; j < 4; ++j) { const int sp = s0 + i - 3 + j;
                P.x[X][hf][j] = *(const u32x4*)(proj + ((size_t)b * SEQ + (sp < 0 ? 0 : sp)) * NPROJ + 8192 + X * 2048 + h * 128 + 16 * cg8 + 8 * hf); }
    if (wid == 0) { const size_t t0 = (size_t)b * SEQ + s0; P.bl = gate[(t0 + lane) * 32 + h]; P.al = gate[(t0 + lane) * 32 + 16 + h]; P.alog = a_log[h]; P.dtb = dt_bias[h]; }
}
__device__ __forceinline__ void dn_prep_chunk(LAS unsigned char* lds, const bf16_t* __restrict__ proj, const float* __restrict__ gate, const float* __restrict__ a_log, const float* __restrict__ dt_bias,
                              bf16_t* __restrict__ Wb, bf16_t* __restrict__ Uf, bf16_t* __restrict__ Qd, bf16_t* __restrict__ Kt, bf16_t* __restrict__ Ab, float* __restrict__ Cd, int chunk, int next_chunk, PrepPre& P) {
    int tid_ = threadIdx.x; asm volatile("" : "+v"(tid_));
    const int tid = tid_, wid = tid >> 6, lane = tid & 63, fr = lane & 15, g = lane >> 4;
    const int bh = chunk >> 7, n = chunk & 127, b = bh >> 4, h = bh & 15;
    const int s0 = n * 64;
    LAS float* cw_s = (LAS float*)(lds + DN_CW);
    LAS float* Ad = (LAS float*)(lds + DN_AD); LAS float* gc_s = (LAS float*)(lds + DN_GC); LAS float* beta_s = (LAS float*)(lds + DN_BETA); LAS float* eg_s = (LAS float*)(lds + DN_EG);
    {
        const int i = tid >> 3, cg8 = tid & 7;
        u32x4 xv2[2][4];
#pragma unroll
        for (int hf = 0; hf < 2; ++hf)
#pragma unroll
            for (int j = 0; j < 4; ++j) { const int sp = s0 + i - 3 + j;
                xv2[hf][j] = *(const u32x4*)(proj + ((size_t)b * SEQ + (sp < 0 ? 0 : sp)) * NPROJ + 8192 + 2 * 2048 + h * 128 + 16 * cg8 + 8 * hf); }
        dn_conv_block<0>(lds, cw_s, P.x[0], s0, i, cg8);
        dn_conv_block<1>(lds, cw_s, P.x[1], s0, i, cg8);
        dn_conv_block<2>(lds, cw_s, xv2, s0, i, cg8);
    }
    if (wid == 0) {
        const float beta = 1.0f / (1.0f + expf(-P.bl));
        const float xx = P.al + P.dtb;
        const float sp = xx > 20.f ? xx : log1pf(expf(xx));
        float gc = -expf(P.alog) * sp;
#pragma unroll
        for (int off = 1; off < 64; off <<= 1) { const float v = __shfl_up(gc, off); if (lane >= off) gc += v; }
        gc_s[lane] = gc; beta_s[lane] = beta; eg_s[lane] = expf(gc);
    }
    LDS_BARRIER();
    if (next_chunk >= 0) dn_prep_prefetch(P, proj, gate, a_log, dt_bias, next_chunk);
    {
        const int type = wid >> 2, ti = wid & 3;
        const int i = 16 * ti + fr; const float gi = gc_s[i], bi = beta_s[i];
#pragma unroll
        for (int tj = 0; tj < 4; ++tj) {
            const size_t aoff = (size_t)chunk * 4096 + ((ti * 2 + (tj >> 1)) * 64 + (2 * (tj & 1) + (g >> 1)) * 16 + fr) * 8 + 4 * (g & 1);
            if (tj > ti) { if (type == 1) *(u32x2*)(Ab + aoff) = (u32x2){0u, 0u}; continue; }
            f32x4 acc = (f32x4){0.f, 0.f, 0.f, 0.f};
            const int xoff = type == 0 ? DN_K : DN_Q;
#pragma unroll
            for (int s = 0; s < 4; ++s) { const bf16x8 a = *(const LAS bf16x8*)(lds + DN_K + (16 * tj + fr) * 272 + (32 * s + 8 * g) * 2), bb = *(const LAS bf16x8*)(lds + xoff + i * 272 + (32 * s + 8 * g) * 2); acc = mfma32(a, bb, acc); }
            float v[4];
#pragma unroll
            for (int reg = 0; reg < 4; ++reg) { const int j = 16 * tj + 4 * g + reg; const float e = __expf(fminf(gi - gc_s[j], 0.f));
                v[reg] = type == 0 ? ((i > j) ? -bi * acc[reg] * e : 0.f) : ((i >= j) ? acc[reg] * e : 0.f); }
            if (type == 1) *(u32x2*)(Ab + aoff) = (u32x2){cvt_pk(v[0], v[1]), cvt_pk(v[2], v[3])};
            else if (tj == ti) *(LAS f32x4*)(Ad + (ti * 16 + fr) * 16 + 4 * g) = (f32x4){-v[0], -v[1], -v[2], -v[3]};
            else *(LAS u32x2*)(lds + DN_ABF + i * 144 + (16 * tj + 4 * g) * 2) = (u32x2){cvt_pk(v[0], v[1]), cvt_pk(v[2], v[3])};
        }
    }
    LDS_BARRIER();
    if (wid == 0) {
        const int bb = lane >> 4, c = lane & 15;
        float t[16];
#pragma unroll
        for (int i = 0; i < 16; ++i) {
            float acc = (i == c) ? 1.0f : 0.0f;
#pragma unroll
            for (int jj = 0; jj < (i + 3) / 4; ++jj) { const f32x4 a4 = *(const LAS f32x4*)(Ad + (bb * 16 + i) * 16 + 4 * jj);
#pragma unroll
                for (int e = 0; e < 4; ++e) if (4 * jj + e < i) acc -= a4[e] * t[4 * jj + e]; }
            t[i] = acc;
            *(LAS bf16_t*)(lds + DN_TBF + ((bb * 16 + i) * 24 + c) * 2) = f2bf(acc);
        }
    } else {
        for (int it = tid - 64; it < 512; it += 448) {
            if (it < 256) { const int i = it >> 2, part = it & 3; const float e = eg_s[i];
#pragma unroll
                for (int c4 = 0; c4 < 4; ++c4) { const u32x4 qv = *(const LAS u32x4*)(lds + DN_Q + i * 272 + part * 64 + c4 * 16);
                    u32x4 o; o.x = cvt_pk(bflo(qv.x) * e, bfhi(qv.x) * e); o.y = cvt_pk(bflo(qv.y) * e, bfhi(qv.y) * e); o.z = cvt_pk(bflo(qv.z) * e, bfhi(qv.z) * e); o.w = cvt_pk(bflo(qv.w) * e, bfhi(qv.w) * e);
                    *(u32x4*)(Qd + (size_t)chunk * 8192 + (((i >> 4) * 4 + part) * 64 + c4 * 16 + (i & 15)) * 8) = o; }
            } else { const int t2 = it - 256, d = t2 & 127, ih = t2 >> 7; const float gl = gc_s[63]; const LAS bf16_t* ks = (const LAS bf16_t*)(lds + DN_K) + d;
#pragma unroll
                for (int i8 = 0; i8 < 4; ++i8) { float v[8];
#pragma unroll
                    for (int e = 0; e < 8; ++e) { const int i = 32 * ih + 8 * i8 + e; v[e] = bf2f(ks[i * 136]) * __expf(gl - gc_s[i]); }
                    *(u32x4*)(Kt + (size_t)chunk * 8192 + (((d >> 4) * 2 + ih) * 64 + i8 * 16 + (d & 15)) * 8) = (u32x4){cvt_pk(v[0], v[1]), cvt_pk(v[2], v[3]), cvt_pk(v[4], v[5]), cvt_pk(v[6], v[7])}; } }
        }
        if (tid == 64) Cd[chunk] = expf(gc_s[63]);
    }
    LDS_BARRIER();
#pragma unroll
    for (int cc = 0; cc < 2; ++cc) {
        const int ct = 2 * wid + cc; const bool isu = ct < 8;
        const LAS bf16_t* src = (const LAS bf16_t*)(lds + (isu ? DN_V : DN_K)) + 16 * (ct & 7) + fr;
        bf16x4 Xb[4];
#pragma unroll
        for (int I = 0; I < 4; ++I) {
            f32x4 acc;
#pragma unroll
            for (int reg = 0; reg < 4; ++reg) { const int i = 16 * I + 4 * g + reg; float r = bf2f(src[i * 136]) * beta_s[i]; if (!isu) r *= eg_s[i]; acc[reg] = r; }
#pragma unroll
            for (int J = 0; J < I; ++J) { const bf16x4 a = *(const LAS bf16x4*)(lds + DN_ABF + (16 * I + fr) * 144 + (16 * J + 4 * g) * 2); acc = mfma16(a, Xb[J], acc); }
            const u32x2 yw = (u32x2){cvt_pk(acc[0], acc[1]), cvt_pk(acc[2], acc[3])};
            const bf16x4 tt = *(const LAS bf16x4*)(lds + DN_TBF + ((I * 16 + fr) * 24 + 4 * g) * 2);
            const f32x4 x = mfma16(tt, __builtin_bit_cast(bf16x4, yw), (f32x4){0.f, 0.f, 0.f, 0.f});
            const u32x2 xw = (u32x2){cvt_pk(x[0], x[1]), cvt_pk(x[2], x[3])};
            Xb[I] = __builtin_bit_cast(bf16x4, xw);
            if (isu) *(u32x2*)(Uf + ((((size_t)chunk * 8 + ct) * 4 + I) * 64 + lane) * 4) = xw;
            else {
#pragma unroll
                for (int reg = 0; reg < 4; ++reg) Wb[(size_t)chunk * 8192 + ((I * 4 + ((16 * (ct - 8) + fr) >> 5)) * 64 + (((16 * (ct - 8) + fr) >> 3) & 3) * 16 + 4 * g + reg) * 8 + (fr & 7)] = (bf16_t)(reg & 1 ? (reg & 2 ? xw.y >> 16 : xw.x >> 16) : (reg & 2 ? xw.y & 0xffffu : xw.x & 0xffffu));
            }
        }
    }
    LDS_BARRIER();
}

struct ScanRegs { bf16x8 f1[4], af[2], kf[2]; u32x2 uv; float cd; };
__device__ __forceinline__ void scan_load(ScanRegs& R, const bf16_t* __restrict__ Wb, const bf16_t* __restrict__ Uf, const bf16_t* __restrict__ Qd, const bf16_t* __restrict__ Kt, const bf16_t* __restrict__ Ab, const float* __restrict__ Cd,
                                          int chunk, int wid, int lane, int fr, int g, int sl) {
    const int tt = wid & 3;
    const bf16_t* src = (wid < 4 ? Wb : Qd) + (size_t)chunk * 8192 + (tt * 4 * 64 + lane) * 8;
#pragma unroll
    for (int s = 0; s < 4; ++s) R.f1[s] = *(const bf16x8*)(src + s * 512);
    R.uv = *(const u32x2*)(Uf + ((((size_t)chunk * 8 + sl) * 4 + tt) * 64 + (wid < 4 ? lane : 0)) * 4);
#pragma unroll
    for (int s = 0; s < 2; ++s) R.af[s] = *(const bf16x8*)(Ab + (size_t)chunk * 4096 + ((tt * 2 + s) * 64 + (wid >= 4 ? lane : 0)) * 8);
#pragma unroll
    for (int s = 0; s < 2; ++s) R.kf[s] = *(const bf16x8*)(Kt + (size_t)chunk * 8192 + ((wid * 2 + s) * 64 + lane) * 8);
    R.cd = Cd[chunk];
}
__device__ __forceinline__ void scan_step(LAS unsigned char* lds, const ScanRegs& R, f32x4& Sacc, bf16_t* __restrict__ orow, size_t ostride, int wid, int fr, int g) {
    f32x4 acc = (f32x4){0.f, 0.f, 0.f, 0.f};
#pragma unroll
    for (int s = 0; s < 4; ++s) { const bf16x8 sf = *(const LAS bf16x8*)(lds + fr * 272 + (32 * s + 8 * g) * 2); acc = mfma32(R.f1[s], sf, acc); }
    const int voff = wid < 4 ? 4352 + fr * 144 + (16 * wid + 4 * g) * 2 : 8192 + (wid * 64 + g * 16 + fr) * 8;
    *(LAS u32x2*)(lds + voff) = (u32x2){cvt_pk(bflo(R.uv.x) - acc[0], bfhi(R.uv.x) - acc[1]), cvt_pk(bflo(R.uv.y) - acc[2], bfhi(R.uv.y) - acc[3])};
    LDS_BARRIER();
    const bf16x8 v0 = *(const LAS bf16x8*)(lds + 4352 + fr * 144 + (8 * g) * 2), v1 = *(const LAS bf16x8*)(lds + 4352 + fr * 144 + (32 + 8 * g) * 2);
    Sacc = Sacc * R.cd;
    Sacc = mfma32(R.kf[0], v0, Sacc); Sacc = mfma32(R.kf[1], v1, Sacc);
    *(LAS u32x2*)(lds + fr * 272 + (16 * wid + 4 * g) * 2) = (u32x2){cvt_pk(Sacc[0], Sacc[1]), cvt_pk(Sacc[2], Sacc[3])};
    acc = mfma32(R.af[0], v0, acc); acc = mfma32(R.af[1], v1, acc);
#pragma unroll
    for (int reg = 0; reg < 4; ++reg) orow[(size_t)reg * ostride] = f2bf(acc[reg]);
    LDS_BARRIER();
}
__device__ void dn_scan_item(LAS unsigned char* lds, const bf16_t* __restrict__ Wb, const bf16_t* __restrict__ Uf, const bf16_t* __restrict__ Qd, const bf16_t* __restrict__ Kt, const bf16_t* __restrict__ Ab, const float* __restrict__ Cd,
                             bf16_t* __restrict__ Odn, bf16_t* __restrict__ dump, int item) {
    const int tid = threadIdx.x, wid = __builtin_amdgcn_readfirstlane(tid >> 6), lane = tid & 63, fr = lane & 15, g = lane >> 4;
    const int bh = (item & 7) + 8 * (item >> 6), sl = (item >> 3) & 7, b = bh >> 4, h = bh & 15;
    f32x4 Sacc = (f32x4){0.f, 0.f, 0.f, 0.f};
    *(LAS u32x2*)(lds + fr * 272 + (16 * wid + 4 * g) * 2) = (u32x2){0u, 0u};
    __syncthreads();
    const int c0 = bh * 128;
    bf16_t* obase = wid >= 4 ? Odn + ((size_t)b * SEQ + 16 * (wid - 4) + 4 * g) * 2048 + h * 128 + 16 * sl + fr : dump + ((size_t)blockIdx.x * 8 + wid) * 64;
    const size_t ostride = wid >= 4 ? 2048 : 0, ostep = wid >= 4 ? (size_t)64 * 2048 : 0;
    ScanRegs R0, R1, R2, R3, R4;
#define SLOAD(R, n) scan_load(R, Wb, Uf, Qd, Kt, Ab, Cd, c0 + (n), wid, lane, fr, g, sl)
#define SSTEP(RC, RP, n) if ((n) < 128) { if ((n) + 4 < 128) SLOAD(RP, (n) + 4); scan_step(lds, RC, Sacc, obase + (size_t)(n) * ostep, ostride, wid, fr, g); }
    SLOAD(R0, 0); SLOAD(R1, 1); SLOAD(R2, 2); SLOAD(R3, 3);
    for (int n = 0; n < 128; n += 5) {
        SSTEP(R0, R4, n) SSTEP(R1, R0, n + 1) SSTEP(R2, R1, n + 2) SSTEP(R3, R2, n + 3) SSTEP(R4, R3, n + 4)
    }
#undef SLOAD
#undef SSTEP
    __syncthreads();
}

__device__ void phase_finalize(const bf16_t* __restrict__ proj, const bf16_t* __restrict__ op, const float* __restrict__ lsep, const bf16_t* __restrict__ Odn, const float* __restrict__ dn_g, bf16_t* __restrict__ mixed) {
    const int tid = threadIdx.x, sub = tid & 15;
    f32x4 g0 = *(const f32x4*)(dn_g + sub * 8), g1 = *(const f32x4*)(dn_g + sub * 8 + 4);
    for (int base = blockIdx.x * 32; base < T_TOK * 16; base += gridDim.x * 32) {
        const int pi = base + (tid >> 4), t = pi >> 4, h = pi & 15;
        { const float l0 = lsep[((size_t)0 * T_TOK + t) * 16 + h], l1 = lsep[((size_t)1 * T_TOK + t) * 16 + h], l2 = lsep[((size_t)2 * T_TOK + t) * 16 + h];
          const float m = fmaxf(l0, fmaxf(l1, l2)); float e0 = __expf(l0 - m), e1 = __expf(l1 - m), e2 = __expf(l2 - m); const float inv = 1.0f / (e0 + e1 + e2); e0 *= inv; e1 *= inv; e2 *= inv;
          const size_t oo = (size_t)t * 2048 + h * 128 + sub * 8;
          const u32x4 a0 = __builtin_nontemporal_load((const u32x4*)(op + oo)), a1 = __builtin_nontemporal_load((const u32x4*)(op + (size_t)T_TOK * 2048 + oo)), a2 = __builtin_nontemporal_load((const u32x4*)(op + (size_t)2 * T_TOK * 2048 + oo));
          const u32x4 gt = __builtin_nontemporal_load((const u32x4*)(proj + (size_t)t * NPROJ + 6144 + h * 128 + sub * 8));
          u32x4 o;
#define MIXW(F) { const float lo = (e0 * bflo(a0.F) + e1 * bflo(a1.F) + e2 * bflo(a2.F)) * silu_f(bflo(gt.F)), hi = (e0 * bfhi(a0.F) + e1 * bfhi(a1.F) + e2 * bfhi(a2.F)) * silu_f(bfhi(gt.F)); o.F = cvt_pk(lo, hi); }
          MIXW(x) MIXW(y) MIXW(z) MIXW(w)
#undef MIXW
          *(u32x4*)(mixed + (size_t)t * DMODEL + h * 128 + sub * 8) = o; }
        { const u32x4 ov = __builtin_nontemporal_load((const u32x4*)(Odn + (size_t)t * 2048 + h * 128 + sub * 8));
          float v[8] = {bflo(ov.x), bfhi(ov.x), bflo(ov.y), bfhi(ov.y), bflo(ov.z), bfhi(ov.z), bflo(ov.w), bfhi(ov.w)};
          float ss = 0.f;
#pragma unroll
          for (int e = 0; e < 8; ++e) ss += v[e] * v[e];
          ss += __shfl_xor(ss, 1); ss += __shfl_xor(ss, 2); ss += __shfl_xor(ss, 4); ss += __shfl_xor(ss, 8);
          const float rstd = rsqrtf(ss * (1.0f / 128.0f) + 1e-6f);
          const u32x4 gt = __builtin_nontemporal_load((const u32x4*)(proj + (size_t)t * NPROJ + 14336 + h * 128 + sub * 8));
          u32x4 o;
          o.x = cvt_pk(v[0] * rstd * g0[0] * silu_f(bflo(gt.x)), v[1] * rstd * g0[1] * silu_f(bfhi(gt.x)));
          o.y = cvt_pk(v[2] * rstd * g0[2] * silu_f(bflo(gt.y)), v[3] * rstd * g0[3] * silu_f(bfhi(gt.y)));
          o.z = cvt_pk(v[4] * rstd * g1[0] * silu_f(bflo(gt.z)), v[5] * rstd * g1[1] * silu_f(bfhi(gt.z)));
          o.w = cvt_pk(v[6] * rstd * g1[2] * silu_f(bflo(gt.w)), v[7] * rstd * g1[3] * silu_f(bfhi(gt.w)));
          *(u32x4*)(mixed + (size_t)t * DMODEL + 2048 + h * 128 + sub * 8) = o; }
    }
}

__device__ void phase_final_norm(const bf16_t* __restrict__ H, float* __restrict__ out, const float* __restrict__ g) {
    const int wid = threadIdx.x >> 6, lane = threadIdx.x & 63;
    const int gw = blockIdx.x * 8 + wid, nw = gridDim.x * 8;
    for (int row = gw; row < T_TOK; row += nw) {
        const u32x4* hr = (const u32x4*)(H + (size_t)row * DMODEL);
        f32x4* orow = (f32x4*)(out + (size_t)row * DMODEL);
        u32x4 v[8]; float ss = 0.f;
#pragma unroll
        for (int i = 0; i < 8; ++i) { v[i] = __builtin_nontemporal_load(hr + i * 64 + lane);
            ss += bflo(v[i].x) * bflo(v[i].x) + bfhi(v[i].x) * bfhi(v[i].x) + bflo(v[i].y) * bflo(v[i].y) + bfhi(v[i].y) * bfhi(v[i].y)
                + bflo(v[i].z) * bflo(v[i].z) + bfhi(v[i].z) * bfhi(v[i].z) + bflo(v[i].w) * bflo(v[i].w) + bfhi(v[i].w) * bfhi(v[i].w); }
        ss = wave_sum(ss);
        const float rstd = rsqrtf(ss * (1.0f / DMODEL) + 1e-6f);
#pragma unroll
        for (int i = 0; i < 8; ++i) { const int e = (i * 64 + lane) * 2; const f32x4 g0 = ((const f32x4*)g)[e], g1 = ((const f32x4*)g)[e + 1];
            __builtin_nontemporal_store((f32x4){bflo(v[i].x), bfhi(v[i].x), bflo(v[i].y), bfhi(v[i].y)} * rstd * g0, orow + e);
            __builtin_nontemporal_store((f32x4){bflo(v[i].z), bfhi(v[i].z), bflo(v[i].w), bfhi(v[i].w)} * rstd * g1, orow + e + 1); }
    }
}

__global__ void __launch_bounds__(512, 2) mega_fwd(Params p) {
    extern __shared__ __attribute__((aligned(16))) unsigned char shm[];
    LAS unsigned char* lds = (LAS unsigned char*)shm;
    cg::grid_group grid = cg::this_grid();
    unsigned char* ws = p.ws;
    bf16_t* xn = (bf16_t*)(ws + OFF_XN); bf16_t* WinT = (bf16_t*)(ws + OFF_WINT); bf16_t* WoutT = (bf16_t*)(ws + OFF_WOUTT); bf16_t* proj = (bf16_t*)(ws + OFF_PROJ);
    float* gate = (float*)(ws + OFF_GATE); bf16_t* mixed = (bf16_t*)(ws + OFF_MIXED); bf16_t* Ab = (bf16_t*)(ws + OFF_AB); float* lsep = (float*)(ws + OFF_LSE); float* Cd = (float*)(ws + OFF_CD);
    bf16_t* Wb = (bf16_t*)(ws + OFF_WB); bf16_t* Ub = (bf16_t*)(ws + OFF_UB); bf16_t* Qd = (bf16_t*)(ws + OFF_QD); bf16_t* Kt = (bf16_t*)(ws + OFF_KT);
    bf16_t* op = (bf16_t*)((unsigned char*)p.out + OUT_OP); bf16_t* Odn = (bf16_t*)((unsigned char*)p.out + OUT_ODN);
    const int G = (int)gridDim.x, c = (int)blockIdx.x;
    volatile LAS unsigned* xst = (volatile LAS unsigned*)(lds + 131072);
    if (threadIdx.x == 0) { xst[0] = 0u; xst[1] = 0u; }
    __syncthreads();
    XcdBarrier xb = xcd_barrier_post((unsigned*)(ws + WS_BAR), xst);

    if (p.mask & 1) for (int rep = 0; rep < REP_P0; ++rep) {
        phase_transpose(lds, p.w_out, DMODEL, DMODEL, DMODEL, WoutT);
        phase_transpose(lds, p.w_in, DMODEL, NIN, NIN, WinT);
        phase_rmsnorm_x(p.x, p.norm_g, xn);
    }
    if (p.coop == 2) grid.sync();
    if (p.coop) xcd_barrier(xb);
    if (p.mask & 2) {
        __syncthreads();
        for (int rb = c; rb < T_TOK / 64; rb += G) gate_gemm(lds, xn, WinT, gate, rb);
        pg8::Gemm g{xn, WinT, T_TOK, NPROJ, DMODEL}; RepOrder S; S.init(T_TOK, NPROJ, G, c); S.reps = REP_G1; EpiProj E{proj, gate};
        pg8::gemm_phase<EpiProj, RepOrder, false>(lds, g, S, E, nullptr);
        __syncthreads();
    }
    if (p.coop) xcd_barrier(xb);
    if (p.mask & 4) {
        { const int per = (N_ATTN_TASKS + G - 1) / G; for (int rep = 0; rep < REP_ATT; ++rep) attn_phase(lds, proj, op, lsep, c * per, (c + 1) * per < N_ATTN_TASKS ? (c + 1) * per : N_ATTN_TASKS); }
        for (int rep = 0; rep < REP_PREP; ++rep) { const int per = (4096 + G - 1) / G; int hprev = -1;
            const int ch0 = c * per, ch1 = (c + 1) * per < 4096 ? (c + 1) * per : 4096;
            PrepPre P;
            if (ch0 < ch1) dn_prep_prefetch(P, proj, gate, p.a_log, p.dt_bias, ch0);
            for (int chunk = ch0; chunk < ch1; ++chunk) { const int hh = (chunk >> 7) & 15;
                if (hh != hprev) { dn_stage_convw(lds, p.conv_w, hh); hprev = hh; }
                dn_prep_chunk(lds, proj, gate, p.a_log, p.dt_bias, Wb, Ub, Qd, Kt, Ab, Cd, chunk, chunk + 1 < ch1 ? chunk + 1 : -1, P); }
            __syncthreads(); }
    }
    if (p.coop) xcd_barrier(xb);
    if (p.mask & 8) {
        for (int rep = 0; rep < REP_SCAN; ++rep) for (int item = c; item < 256; item += G) dn_scan_item(lds, Wb, Ub, Qd, Kt, Ab, Cd, Odn, (bf16_t*)(ws + WS_END), item);
    }
    if (p.coop) xcd_barrier(xb);
    if (p.mask & 16) for (int rep = 0; rep < REP_FIN; ++rep) phase_finalize(proj, op, lsep, Odn, p.dn_norm_g, mixed);
    if (p.coop) xcd_barrier(xb);
    if (p.mask & 32) {
        __syncthreads();
        pg8::Gemm g{mixed, WoutT, T_TOK, DMODEL, DMODEL}; pg8::StaticOrder S; S.init(T_TOK, DMODEL, G, c); EpiResidBf E{proj  , p.x};
        pg8::gemm_phase<EpiResidBf, pg8::StaticOrder, false>(lds, g, S, E, nullptr);
        __syncthreads();
    }
    if (p.coop) xcd_barrier(xb);
    if (p.mask & 64) phase_final_norm(proj, p.out, p.final_g);
}

extern "C" void kernel_launch(void* const* d_in, const int* in_sizes, int n_in, void* d_out, int out_size, void* d_ws, size_t ws_size, hipStream_t stream) {
    static int grid = 0;
    if (grid == 0) {
        if (n_in != 9 || out_size != T_TOK * DMODEL || ws_size < WS_BAR + XCD_BAR_WORDS * 4) { fprintf(stderr, "kernel_launch: unexpected shapes (n_in %d out %d ws %zu)\n", n_in, out_size, ws_size); grid = -1; return; }
        int dev = 0, cus = 0, per_cu = 0;
        hipGetDevice(&dev); hipDeviceGetAttribute(&cus, hipDeviceAttributeMultiprocessorCount, dev);
        if (hipFuncSetAttribute((const void*)mega_fwd, hipFuncAttributeMaxDynamicSharedMemorySize, LDS_BYTES) != hipSuccess) { fprintf(stderr, "kernel_launch: hipFuncSetAttribute failed\n"); grid = -1; return; }
        if (hipOccupancyMaxActiveBlocksPerMultiprocessor(&per_cu, (const void*)mega_fwd, 512, LDS_BYTES) != hipSuccess || per_cu < 1) { fprintf(stderr, "kernel_launch: occupancy query gives %d\n", per_cu); per_cu = 1; }
        (void)hipGetLastError();
        grid = cus * 1;
    }
    if (grid < 0) return;
    if (hipMemsetAsync((char*)d_ws + WS_BAR, 0, XCD_BAR_WORDS * 4, stream) != hipSuccess) { fprintf(stderr, "kernel_launch: memset of barrier words failed\n"); return; }
    Params p{};
    p.x = (const float*)d_in[0]; p.norm_g = (const float*)d_in[1]; p.w_in = (const float*)d_in[2]; p.conv_w = (const float*)d_in[3]; p.a_log = (const float*)d_in[4];
    p.dt_bias = (const float*)d_in[5]; p.dn_norm_g = (const float*)d_in[6]; p.w_out = (const float*)d_in[7]; p.final_g = (const float*)d_in[8];
    p.out = (float*)d_out; p.ws = (unsigned char*)d_ws;
#if MK_COOP
    p.mask = 127; p.coop = 1;
    void* args[] = {&p};
    hipError_t e = hipLaunchCooperativeKernel((const void*)mega_fwd, dim3(grid), dim3(512), args, LDS_BYTES, stream);
    if (e != hipSuccess) fprintf(stderr, "cooperative launch failed: %s (grid %d)\n", hipGetErrorString(e), grid);
#else
    p.coop = 0;
    for (int ph = 0; ph < 7; ++ph) { p.mask = 1 << ph; hipLaunchKernelGGL(mega_fwd, dim3(grid), dim3(512), LDS_BYTES, stream, p); }
#endif
}
```
